# Optimizing an MI355X kernel written in HIP

```python
import math
import jax, jax.numpy as jnp
from jax import lax
import numpy as np

D_MODEL = 1024
BATCH = 2
SEQ = 16384
DEPTH = 4

HEAD_DIM = 64
N_MIX_HEADS = 8
N_MEM_HEADS = 4
MIX_WIDTH = N_MIX_HEADS * HEAD_DIM
MEM_WIDTH = N_MEM_HEADS * HEAD_DIM
MERGED_WIDTH = MIX_WIDTH + MEM_WIDTH
N_MEM = 256
D_FF = 4 * D_MODEL
BLOCK_Q = 128
GROUP_Q = 1024
N_A = DEPTH // 2
N_B = DEPTH - N_A
W_IN_A = 3 * MIX_WIDTH + MEM_WIDTH
W_IN_B = MIX_WIDTH + MEM_WIDTH
W_KV_SHARED = 2 * MIX_WIDTH + N_MIX_HEADS
EPS = 1e-6
NEG_INF = -1e30
FORGET_BIAS_INIT = 2.0

kernel_name = "yoco_stickbreak_fox_hybrid"


def rms_norm(x, g):
    xf = x.astype(jnp.float32)
    y = xf * lax.rsqrt(jnp.mean(xf * xf, axis=-1, keepdims=True) + EPS) * g.astype(jnp.float32)
    return y.astype(x.dtype)


def split_heads(t, n_heads):
    b, s, _ = t.shape
    return t.reshape(b, s, n_heads, HEAD_DIM).transpose(0, 2, 1, 3)


def merge_heads(t):
    b, h, s, d = t.shape
    return t.transpose(0, 2, 1, 3).reshape(b, s, h * d)


def to_blocks(t):
    b, h, s = t.shape[:3]
    t = t.reshape((b, h, s // BLOCK_Q, BLOCK_Q) + t.shape[3:])
    return jnp.moveaxis(t, 2, 0)


def from_blocks(t):
    nb, b, h, blk, d = t.shape
    return jnp.moveaxis(t, 0, 2).reshape(b, h, nb * blk, d)


def causal_sweep(block_fn, q_side, kv_side):
    s_len = q_side[0].shape[2]
    outs = []
    for g0 in range(0, s_len, GROUP_Q):
        g1 = min(g0 + GROUP_Q, s_len)
        kv_g = tuple(t[:, :, :g1] for t in kv_side)
        q_blocks = tuple(to_blocks(t[:, :, g0:g1]) for t in q_side)
        starts = g0 + jnp.arange((g1 - g0) // BLOCK_Q) * BLOCK_Q

        def body(args, kv_g=kv_g):
            return block_fn(*args, *kv_g)

        outs.append(from_blocks(lax.map(body, q_blocks + (starts,))))
    return jnp.concatenate(outs, axis=2)


def _stick_breaking_block(q_blk, t0, k, v):
    scale = 1.0 / math.sqrt(HEAD_DIM)
    z = jnp.einsum('bhqd,bhkd->bhqk', q_blk, k).astype(jnp.float32) * scale
    key_pos = jnp.arange(k.shape[2])
    t_pos = t0 + jnp.arange(BLOCK_Q)
    mask = key_pos[None, :] < t_pos[:, None]
    log_one_minus = jnp.where(mask, jax.nn.log_sigmoid(-z), 0.0)
    between = lax.cumsum(log_one_minus, axis=3, reverse=True) - log_one_minus
    w = jnp.where(mask, jnp.exp(jax.nn.log_sigmoid(z) + between), 0.0)
    return jnp.einsum('bhqk,bhkd->bhqd', w.astype(v.dtype), v)


def stick_breaking_attention(q, k, v):
    return causal_sweep(_stick_breaking_block, (q,), (k, v))


def _forgetting_block(q_blk, c_blk, t0, k, v, c_k):
    scale = 1.0 / math.sqrt(HEAD_DIM)
    z = jnp.einsum('bhqd,bhkd->bhqk', q_blk, k).astype(jnp.float32) * scale
    z = z + c_blk[..., :, None] - c_k[:, :, None, :]
    key_pos = jnp.arange(k.shape[2])
    t_pos = t0 + jnp.arange(BLOCK_Q)
    mask = key_pos[None, :] <= t_pos[:, None]
    p = jax.nn.softmax(jnp.where(mask, z, NEG_INF), axis=-1)
    return jnp.einsum('bhqk,bhkd->bhqd', p.astype(v.dtype), v)


def forgetting_attention(q, k, v, log_f_cum):
    return causal_sweep(_forgetting_block, (q, log_f_cum), (k, v, log_f_cum))


def memory_attention(q_mem, mem_k, mem_v):
    scale = 1.0 / math.sqrt(HEAD_DIM)
    s = jnp.einsum('bshd,bmhd->bhsm', q_mem, mem_k).astype(jnp.float32) * scale
    p = jax.nn.softmax(s, axis=-1)
    o = jnp.einsum('bhsm,bmhd->bshd', p.astype(mem_v.dtype), mem_v)
    b, sl = q_mem.shape[:2]
    return o.reshape(b, sl, MEM_WIDTH)


def squared_relu_mlp(x, w1, w2):
    h = jnp.square(jax.nn.relu(x @ w1))
    return h @ w2


def setup_inputs(seed: int = 0) -> dict:
    key = jax.random.key(seed)
    ks = jax.random.split(key, 16)
    f32 = jnp.float32
    nrm = lambda k, shape, s: (jax.random.normal(k, shape, f32) * s).astype(f32)
    x = jax.random.normal(ks[0], (BATCH, SEQ, D_MODEL), f32)
    mem = jax.random.normal(ks[1], (BATCH, N_MEM, D_MODEL), f32)
    norm1_g = 1.0 + nrm(ks[2], (DEPTH, D_MODEL), 0.02)
    w_in_a = nrm(ks[3], (N_A, D_MODEL, W_IN_A), D_MODEL ** -0.5)
    w_in_b = nrm(ks[4], (N_B, D_MODEL, W_IN_B), D_MODEL ** -0.5)
    w_mem_kv = nrm(ks[5], (DEPTH, D_MODEL, 2 * MEM_WIDTH), D_MODEL ** -0.5)
    mem_norm_g = 1.0 + nrm(ks[6], (DEPTH, D_MODEL), 0.02)
    w_o = nrm(ks[7], (DEPTH, MERGED_WIDTH, D_MODEL), MERGED_WIDTH ** -0.5)
    norm2_g = 1.0 + nrm(ks[8], (DEPTH, D_MODEL), 0.02)
    w_mlp1 = nrm(ks[9], (DEPTH, D_MODEL, D_FF), D_MODEL ** -0.5)
    w_mlp2 = nrm(ks[10], (DEPTH, D_FF, D_MODEL), D_FF ** -0.5)
    kv_norm_g = 1.0 + nrm(ks[11], (D_MODEL,), 0.02)
    w_kv_shared = nrm(ks[12], (D_MODEL, W_KV_SHARED), D_MODEL ** -0.5)
    b_f = FORGET_BIAS_INIT + nrm(ks[13], (N_MIX_HEADS,), 0.1)
    final_norm_g = 1.0 + nrm(ks[14], (D_MODEL,), 0.02)
    return {"x": x, "mem": mem, "norm1_g": norm1_g, "w_in_a": w_in_a, "w_in_b": w_in_b,
            "w_mem_kv": w_mem_kv, "mem_norm_g": mem_norm_g, "w_o": w_o, "norm2_g": norm2_g,
            "w_mlp1": w_mlp1, "w_mlp2": w_mlp2, "kv_norm_g": kv_norm_g,
            "w_kv_shared": w_kv_shared, "b_f": b_f, "final_norm_g": final_norm_g}


def reference(x, mem, norm1_g, w_in_a, w_in_b, w_mem_kv, mem_norm_g, w_o, norm2_g,
              w_mlp1, w_mlp2, kv_norm_g, w_kv_shared, b_f, final_norm_g):
    b, s_len, _ = x.shape
    m_len = mem.shape[1]
    h = x
    k_sh = v_sh = log_f_cum = None
    for l in range(DEPTH):
        if l == N_A:
            hs = rms_norm(h, kv_norm_g)
            kvf = hs @ w_kv_shared
            k_sh = split_heads(kvf[..., :MIX_WIDTH], N_MIX_HEADS)
            v_sh = split_heads(kvf[..., MIX_WIDTH:2 * MIX_WIDTH], N_MIX_HEADS)
            f_logit = kvf[..., 2 * MIX_WIDTH:].astype(jnp.float32) + b_f.astype(jnp.float32)
            log_f_cum = jnp.moveaxis(lax.cumsum(jax.nn.log_sigmoid(f_logit), axis=1), 1, 2)

        hn = rms_norm(h, norm1_g[l])
        mkv = rms_norm(mem, mem_norm_g[l]) @ w_mem_kv[l]
        mem_k = mkv[..., :MEM_WIDTH].reshape(b, m_len, N_MEM_HEADS, HEAD_DIM)
        mem_v = mkv[..., MEM_WIDTH:].reshape(b, m_len, N_MEM_HEADS, HEAD_DIM)

        if l < N_A:
            proj = hn @ w_in_a[l]
            q = split_heads(proj[..., :MIX_WIDTH], N_MIX_HEADS)
            k = split_heads(proj[..., MIX_WIDTH:2 * MIX_WIDTH], N_MIX_HEADS)
            v = split_heads(proj[..., 2 * MIX_WIDTH:3 * MIX_WIDTH], N_MIX_HEADS)
            q_mem = proj[..., 3 * MIX_WIDTH:]
            mix = stick_breaking_attention(q, k, v)
        else:
            proj = hn @ w_in_b[l - N_A]
            q = split_heads(proj[..., :MIX_WIDTH], N_MIX_HEADS)
            q_mem = proj[..., MIX_WIDTH:]
            mix = forgetting_attention(q, k_sh, v_sh, log_f_cum)

        mem_out = memory_attention(q_mem.reshape(b, s_len, N_MEM_HEADS, HEAD_DIM), mem_k, mem_v)
        merged = jnp.concatenate([merge_heads(mix), mem_out], axis=-1)
        h = h + merged @ w_o[l]
        h = h + squared_relu_mlp(rms_norm(h, norm2_g[l]), w_mlp1[l], w_mlp2[l])
    return rms_norm(h, final_norm_g)
```

```cpp
#include <hip/hip_runtime.h>
#include <hip/hip_cooperative_groups.h>
#include <cstdio>
#include <cstdint>
namespace cg = cooperative_groups;
namespace pg8 {
#define PG8_LAS __attribute__((address_space(3)))
typedef unsigned short bf16_t;
typedef short bf16x8 __attribute__((ext_vector_type(8)));
typedef float f32x4 __attribute__((ext_vector_type(4)));
typedef unsigned u32x4 __attribute__((ext_vector_type(4)));
constexpr int BM = 256, BK = 64, HALF = 128, HTB = HALF * BK * 2  , STAGE_BYTES = 8 * HTB, NXCD = 8, WGM = 8;

__host__ __device__ __forceinline__ int lds_byte(int r, int c) { const int st = (r >> 4) * 2 + (c >> 5), rr = r & 15, cc = c & 31, ob = rr * 64 + cc * 2; return st * 1024 + (ob ^ (((ob >> 9) & 1) << 5)); }
__host__ __device__ __forceinline__ void stage_rc(int b, int& R, int& C) { const int st = b / 1024, sb = b % 1024, swz = sb ^ (((sb >> 9) & 1) << 5); R = (st >> 1) * 16 + swz / 64; C = (st & 1) * 32 + (swz % 64) / 2; }
__host__ __device__ __forceinline__ int perm32(int rho) { const int n = rho >> 4, i = rho & 15; return 8 * (i >> 2) + 4 * n + (i & 3); }

struct Unit { int pm, pn; };
struct Gemm { const bf16_t* A; const bf16_t* Bt; int M, N, K; };

struct StaticOrder {
    int nM, nN, nwg, G, c;
    __host__ __device__ void init(int M, int N, int G_, int c_) { nM = M / BM; nN = N / BM; nwg = nM * nN; G = G_; c = c_; }
    __host__ __device__ bool next(int i, Unit& u) const {
        const long L = (long)i * G + c; if (L >= nwg) return false;
        int wgid = (int)L; { const int q = nwg / NXCD, r = nwg % NXCD, xcd = wgid % NXCD, off = wgid / NXCD; wgid = (xcd < r ? xcd * (q + 1) : r * (q + 1) + (xcd - r) * q) + off; }
        const int nig = WGM * nN, gid = wgid / nig, fm = gid * WGM, gsz = (nM - fm) < WGM ? (nM - fm) : WGM;
        u.pm = fm + ((wgid % nig) % gsz); u.pn = (wgid % nig) / gsz; return true;
    }
    __device__ __forceinline__ void a_ready(const Unit&) const {}
    __device__ __forceinline__ void done(const Unit&) const {}
};
__device__ __forceinline__ unsigned cvt_pk_bf16(float lo, float hi) { unsigned r; asm volatile("v_cvt_pk_bf16_f32 %0, %1, %2" : "=v"(r) : "v"(lo), "v"(hi)); return r; }
constexpr float RMS_EPS = 1e-6f;
typedef unsigned u32x2 __attribute__((ext_vector_type(2)));
#define PG8_GAS __attribute__((address_space(1)))
struct EpiProj {
    static constexpr bool PERM = true, AFTER_DRAIN = false;
    const float* ss; bf16_t* O; int ldc; int act; int cat; bf16_t* Ksh; bf16_t* Vsh; float* flog;
    __device__ __forceinline__ void operator()(const f32x4 (&acc)[2][2][4][2], const Unit& u, int wr, int wc, int fr, int fq) const {
        const int row0 = u.pm * BM + wr * 64 + fr;
        bf16_t* base = O; int ld = ldc; int colt = u.pn * BM; int kind = 0;
        if (cat) { if (u.pn >= 7) kind = 2; else if (u.pn >= 5) { base = Vsh; ld = 512; colt = (u.pn - 5) * BM; } else if (u.pn >= 3) { base = Ksh; ld = 512; colt = (u.pn - 3) * BM; } }
        const int col0 = colt + wc * 32 + 8 * fq;
        f32x4 sv[2][4];
#pragma unroll
        for (int ai = 0; ai < 2; ++ai)
#pragma unroll
            for (int m = 0; m < 4; ++m) sv[ai][m] = *(const PG8_GAS f32x4*)(ss + (size_t)(row0 + ai * HALF + m * 16) * 4);
#pragma unroll
        for (int ai = 0; ai < 2; ++ai)
#pragma unroll
            for (int m = 0; m < 4; ++m) {
                const int row = row0 + ai * HALF + m * 16;
                const f32x4 sa = sv[ai][m];
                const float t = (sa[0] + sa[1]) + (sa[2] + sa[3]);
                const float rs = __builtin_amdgcn_rsqf(t * (1.0f / 1024.0f) + RMS_EPS);
                if (kind == 2) {
                    if (wc == 0 && fq == 0) { const f32x4 v0 = acc[ai][0][m][0] * rs, v1 = acc[ai][0][m][1] * rs; *(PG8_GAS f32x4*)(flog + (size_t)row * 8) = v0; *(PG8_GAS f32x4*)(flog + (size_t)row * 8 + 4) = v1; }
                } else {
                    bf16_t* rowp = base + (size_t)row * ld + col0;
#pragma unroll
                    for (int bj = 0; bj < 2; ++bj) {
                        f32x4 v0 = acc[ai][bj][m][0] * rs, v1 = acc[ai][bj][m][1] * rs;
                        if (act) {
#pragma unroll
                            for (int j = 0; j < 4; ++j) { const float a = fmaxf(v0[j], 0.f), b = fmaxf(v1[j], 0.f); v0[j] = a * a; v1[j] = b * b; }
                        }
                        u32x4 w; w.x = cvt_pk_bf16(v0[0], v0[1]); w.y = cvt_pk_bf16(v0[2], v0[3]); w.z = cvt_pk_bf16(v1[0], v1[1]); w.w = cvt_pk_bf16(v1[2], v1[3]);
                        *(PG8_GAS u32x4*)(rowp + bj * HALF) = w;
                    }
                }
            }
    }
};
__device__ __forceinline__ float bf_lo(unsigned w) { return __uint_as_float(w << 16); }
__device__ __forceinline__ float bf_hi(unsigned w) { return __uint_as_float(w & 0xffff0000u); }
struct EpiRes {
    static constexpr bool PERM = false, AFTER_DRAIN = false;
    bf16_t* hb; float* ss; PG8_LAS float* red;
    __device__ __forceinline__ void operator()(const f32x4 (&acc)[2][2][4][2], const Unit& u, int wr, int wc, int fr, int fq) const {
        const int col0 = u.pn * BM + wc * 32 + 4 * fq;
#pragma unroll
        for (int ai = 0; ai < 2; ++ai) {
            u32x2 b[4][2][2];
#pragma unroll
            for (int m = 0; m < 4; ++m) {
                const size_t off = (size_t)(u.pm * BM + ai * HALF + wr * 64 + m * 16 + fr) * 1024 + col0;
#pragma unroll
                for (int bj = 0; bj < 2; ++bj)
#pragma unroll
                    for (int n = 0; n < 2; ++n) b[m][bj][n] = *(const PG8_GAS u32x2*)(hb + off + bj * HALF + n * 16);
            }
#pragma unroll
            for (int m = 0; m < 4; ++m) {
                const int rt = ai * HALF + wr * 64 + m * 16 + fr; const size_t off = (size_t)(u.pm * BM + rt) * 1024 + col0; float q = 0.f;
#pragma unroll
                for (int bj = 0; bj < 2; ++bj)
#pragma unroll
                    for (int n = 0; n < 2; ++n) {
                        const f32x4 a = acc[ai][bj][m][n]; const u32x2 bb = b[m][bj][n];
                        u32x2 w; w.x = cvt_pk_bf16(bf_lo(bb.x) + a[0], bf_hi(bb.x) + a[1]); w.y = cvt_pk_bf16(bf_lo(bb.y) + a[2], bf_hi(bb.y) + a[3]);
                        *(PG8_GAS u32x2*)(hb + off + bj * HALF + n * 16) = w;
                        const float o0 = bf_lo(w.x), o1 = bf_hi(w.x), o2 = bf_lo(w.y), o3 = bf_hi(w.y);
                        q += (o0 * o0 + o1 * o1) + (o2 * o2 + o3 * o3);
                    }
                q += __shfl_xor(q, 16); q += __shfl_xor(q, 32);
                if (fq == 0) red[rt * 4 + wc] = q;
            }
            asm volatile("" ::: "memory");
        }
        asm volatile("s_waitcnt lgkmcnt(0)" ::: "memory"); __builtin_amdgcn_s_barrier(); asm volatile("" ::: "memory");
        const int t = threadIdx.x;
        if (t < 256) { const f32x4 v = *(const PG8_LAS f32x4*)(red + t * 4); *(PG8_GAS float*)(ss + (size_t)(u.pm * BM + t) * 4 + u.pn) = (v[0] + v[1]) + (v[2] + v[3]); }
    }
};
template <class Epi, class Sched, bool ALIGN_EPI = false, bool SP2 = false>
__device__ __forceinline__ void gemm_phase(PG8_LAS unsigned char* lds, const Gemm g, const Sched& S, const Epi& E) {
    int tid_l = threadIdx.x; asm volatile("" : "+v"(tid_l));
    const int tid = tid_l, wid = __builtin_amdgcn_readfirstlane(tid >> 6), lane = tid & 63, wr = wid >> 2, wc = wid & 3, fr = lane & 15, fq = lane >> 4;
    const int K = g.K, nt = K / BK;
    unsigned voffA[2], voffB[2];
#pragma unroll
    for (int i = 0; i < 2; ++i) { int R, C; stage_rc(tid * 16 + i * 8192, R, C); const int Rb = Epi::PERM ? ((R & ~31) + perm32(R & 31)) : R;
        voffA[i] = (unsigned)(R * K + C) * 2u; voffB[i] = (unsigned)(Rb * K + C) * 2u; }
    const size_t kstep = (size_t)(BK * 2);
    const size_t hstep = (size_t)HALF * K * 2;
    const size_t tstep = 2 * hstep;
    const unsigned ldsw = (unsigned)wid * 1024u;
    const int aoff = lds_byte(wr * 64 + fr, fq * 8), boff = lds_byte(wc * 32 + fr, fq * 8);
#define PG8_SA(b, h) (((b) * 2 + (h)) * HTB)
#define PG8_SB(b, h) ((4 + (b) * 2 + (h)) * HTB)
#define PG8_STAGE(bufoff, gbase, voff) do { _Pragma("unroll") for (int _i = 0; _i < 2; ++_i) \
        __builtin_amdgcn_global_load_lds((const unsigned*)((const char*)(gbase) + (voff)[_i]), (PG8_LAS unsigned*)(lds + (bufoff) + ldsw + _i * 8192), 16, 0, 0); } while (0)
#define PG8_LDA(dst, b, h) do { _Pragma("unroll") for (int m = 0; m < 4; ++m) _Pragma("unroll") for (int k = 0; k < 2; ++k) dst[m][k] = *(const PG8_LAS bf16x8*)(lds + PG8_SA(b, h) + aoff + m * 2048 + k * 1024); } while (0)
#define PG8_LDB(dst, b, h) do { _Pragma("unroll") for (int n = 0; n < 2; ++n) _Pragma("unroll") for (int k = 0; k < 2; ++k) dst[n][k] = *(const PG8_LAS bf16x8*)(lds + PG8_SB(b, h) + boff + n * 2048 + k * 1024); } while (0)
#define PG8_MMA(ai, bj, At, Bt) do { __builtin_amdgcn_s_setprio(1); _Pragma("unroll") for (int m = 0; m < 4; ++m) _Pragma("unroll") for (int n = 0; n < 2; ++n) _Pragma("unroll") for (int k = 0; k < 2; ++k) \
        acc[ai][bj][m][n] = __builtin_amdgcn_mfma_f32_16x16x32_bf16(Bt[n][k], At[m][k], acc[ai][bj][m][n], 0, 0, 0); __builtin_amdgcn_s_setprio(0); } while (0)
#define PG8_WAIT_V(n) asm volatile("s_waitcnt vmcnt(" #n ")" ::: "memory")
#define PG8_WAIT_L(n) asm volatile("s_waitcnt lgkmcnt(" #n ")" ::: "memory")
#define PG8_BAR __builtin_amdgcn_s_barrier()
#define PG8_SCHED __builtin_amdgcn_sched_barrier(0)
    Unit cur, nxt; int ui = 0;
    if (!S.next(0, cur)) return;
    f32x4 acc[2][2][4][2];
#pragma unroll
    for (int a = 0; a < 2; ++a)
#pragma unroll
        for (int b = 0; b < 2; ++b)
#pragma unroll
            for (int m = 0; m < 4; ++m)
#pragma unroll
                for (int n = 0; n < 2; ++n) acc[a][b][m][n] = (f32x4){0.f, 0.f, 0.f, 0.f};
    bf16x8 At[4][2], B0[2][2], B1[2][2];
    const char* cA = (const char*)g.A + (size_t)cur.pm * tstep; const char* cB = (const char*)g.Bt + (size_t)cur.pn * tstep;
    S.a_ready(cur);
    if constexpr (SP2) {
        PG8_STAGE(PG8_SB(0, 0), cB, voffB); PG8_STAGE(PG8_SB(0, 1), cB + hstep, voffB); PG8_STAGE(PG8_SA(0, 0), cA, voffA); PG8_STAGE(PG8_SA(0, 1), cA + hstep, voffA);
        if (wr == 1) PG8_BAR;
        PG8_WAIT_V(2); PG8_BAR;
        PG8_STAGE(PG8_SB(1, 0), cB + kstep, voffB); PG8_STAGE(PG8_SA(1, 0), cA + kstep, voffA); PG8_STAGE(PG8_SB(1, 1), cB + hstep + kstep, voffB);
        PG8_WAIT_V(6); PG8_BAR;
    } else {
        PG8_STAGE(PG8_SB(0, 0), cB, voffB); PG8_STAGE(PG8_SA(0, 0), cA, voffA); PG8_STAGE(PG8_SB(0, 1), cB + hstep, voffB); PG8_STAGE(PG8_SA(0, 1), cA + hstep, voffA);
        if (wr == 1) PG8_BAR;
        PG8_WAIT_V(4); PG8_BAR;
        PG8_STAGE(PG8_SB(1, 0), cB + kstep, voffB); PG8_STAGE(PG8_SA(1, 0), cA + kstep, voffA); PG8_STAGE(PG8_SB(1, 1), cB + hstep + kstep, voffB);
        PG8_WAIT_V(6); PG8_BAR;
    }
    for (;;) {
        const bool has_next = S.next(ui + 1, nxt);
        const char* nA = has_next ? (const char*)g.A + (size_t)nxt.pm * tstep : cA; const char* nB = has_next ? (const char*)g.Bt + (size_t)nxt.pn * tstep : cB;
        for (int t = 0; t < nt; t += 2) {
            const bool last = (t == nt - 2);
            const char* a1 = cA + (size_t)(t + 1) * kstep;
            const char* a2 = last ? nA : cA + (size_t)(t + 2) * kstep; const char* b2 = last ? nB : cB + (size_t)(t + 2) * kstep;
            const char* a3 = a2 + kstep; const char* b3 = b2 + kstep;
            if (last && has_next) S.a_ready(nxt);
            if constexpr (SP2) {
            PG8_LDB(B0, 0, 0); PG8_LDB(B1, 0, 1); PG8_SCHED; PG8_LDA(At, 0, 0); PG8_STAGE(PG8_SA(1, 1), a1 + hstep, voffA);
            PG8_WAIT_V(8); PG8_WAIT_L(0); PG8_BAR; PG8_MMA(0, 0, At, B0); PG8_MMA(0, 1, At, B1); PG8_BAR; PG8_SCHED;
            PG8_LDA(At, 0, 1); PG8_STAGE(PG8_SB(0, 0), b2, voffB); PG8_STAGE(PG8_SB(0, 1), b2 + hstep, voffB); PG8_STAGE(PG8_SA(0, 0), a2, voffA);
            PG8_WAIT_V(8); PG8_WAIT_L(0); PG8_BAR; PG8_MMA(1, 0, At, B0); PG8_MMA(1, 1, At, B1); PG8_BAR; PG8_SCHED;
            PG8_LDB(B0, 1, 0); PG8_LDB(B1, 1, 1); PG8_SCHED; PG8_LDA(At, 1, 0); PG8_STAGE(PG8_SA(0, 1), a2 + hstep, voffA);
            PG8_WAIT_V(8); PG8_WAIT_L(0); PG8_BAR; PG8_MMA(0, 0, At, B0); PG8_MMA(0, 1, At, B1); PG8_BAR; PG8_SCHED;
            PG8_LDA(At, 1, 1); PG8_STAGE(PG8_SB(1, 0), b3, voffB); PG8_STAGE(PG8_SB(1, 1), b3 + hstep, voffB); PG8_STAGE(PG8_SA(1, 0), a3, voffA);
            PG8_WAIT_V(8); PG8_WAIT_L(0); PG8_BAR; PG8_MMA(1, 0, At, B0); PG8_MMA(1, 1, At, B1); PG8_BAR; PG8_SCHED;
            } else {
            PG8_LDB(B0, 0, 0); PG8_SCHED; PG8_LDA(At, 0, 0); PG8_STAGE(PG8_SA(1, 1), a1 + hstep, voffA);
            PG8_WAIT_L(8); PG8_BAR; PG8_WAIT_L(0); PG8_MMA(0, 0, At, B0); PG8_BAR; PG8_SCHED;
            PG8_LDB(B1, 0, 1); PG8_STAGE(PG8_SB(0, 0), b2, voffB);
            PG8_BAR; PG8_WAIT_L(0); PG8_MMA(0, 1, At, B1); PG8_BAR;
            PG8_LDA(At, 0, 1); PG8_STAGE(PG8_SA(0, 0), a2, voffA);
            PG8_BAR; PG8_WAIT_L(0); PG8_MMA(1, 0, At, B0); PG8_BAR; PG8_SCHED;
            PG8_STAGE(PG8_SB(0, 1), b2 + hstep, voffB);
            PG8_WAIT_V(6); PG8_BAR; PG8_MMA(1, 1, At, B1); PG8_BAR;
            PG8_LDB(B0, 1, 0); PG8_SCHED; PG8_LDA(At, 1, 0); PG8_STAGE(PG8_SA(0, 1), a2 + hstep, voffA);
            PG8_WAIT_L(8); PG8_BAR; PG8_WAIT_L(0); PG8_MMA(0, 0, At, B0); PG8_BAR; PG8_SCHED;
            PG8_LDB(B1, 1, 1); PG8_STAGE(PG8_SB(1, 0), b3, voffB);
            PG8_BAR; PG8_WAIT_L(0); PG8_MMA(0, 1, At, B1); PG8_BAR;
            PG8_LDA(At, 1, 1); PG8_STAGE(PG8_SA(1, 0), a3, voffA);
            PG8_BAR; PG8_WAIT_L(0); PG8_MMA(1, 0, At, B0); PG8_BAR; PG8_SCHED;
            PG8_STAGE(PG8_SB(1, 1), b3 + hstep, voffB);
            PG8_WAIT_V(6); PG8_BAR; PG8_MMA(1, 1, At, B1); PG8_BAR;
            }
        }
        if constexpr (ALIGN_EPI) { if (wr == 0) PG8_BAR; }
        if constexpr (!Epi::AFTER_DRAIN) { E(acc, cur, wr, wc, fr, fq); S.done(cur); }
        if (!has_next) break;
#pragma unroll
        for (int a = 0; a < 2; ++a)
#pragma unroll
            for (int b = 0; b < 2; ++b)
#pragma unroll
                for (int m = 0; m < 4; ++m)
#pragma unroll
                    for (int n = 0; n < 2; ++n) acc[a][b][m][n] = (f32x4){0.f, 0.f, 0.f, 0.f};
        cur = nxt; cA = nA; cB = nB; ++ui;
        if constexpr (ALIGN_EPI) { if (wr == 1) PG8_BAR; }
    }
    PG8_WAIT_V(0);
    if constexpr (!ALIGN_EPI) { if (wr == 0) PG8_BAR; }
    PG8_BAR;
    if constexpr (Epi::AFTER_DRAIN) { E.fused(acc, cur, wr, wc, fr, fq, lds, wid, lane); S.done(cur); }
#undef PG8_SA
#undef PG8_SB
#undef PG8_STAGE
#undef PG8_LDA
#undef PG8_LDB
#undef PG8_MMA
#undef PG8_WAIT_V
#undef PG8_WAIT_L
#undef PG8_BAR
#undef PG8_SCHED
}
}
constexpr int D_MODEL = 1024, NBATCH = 2, SEQ = 16384, MROWS = NBATCH * SEQ, DFF = 4096, NMEM = 256, MEMROWS = NBATCH * NMEM;
constexpr int NTHREADS = 512, NWAVES = 8;
#define LAS __attribute__((address_space(3)))
#define GAS __attribute__((address_space(1)))
typedef pg8::bf16_t bf16_t;
typedef pg8::bf16x8 bf16x8;
typedef float f32x4 __attribute__((ext_vector_type(4)));
typedef float f32x16 __attribute__((ext_vector_type(16)));
typedef unsigned u32x4 __attribute__((ext_vector_type(4)));
typedef unsigned u32x2 __attribute__((ext_vector_type(2)));
typedef short s16x4 __attribute__((ext_vector_type(4)));
typedef float f32x2_t __attribute__((ext_vector_type(2)));
typedef __bf16 bf16x2_t __attribute__((ext_vector_type(2)));
#define LDS_WAIT() asm volatile("s_waitcnt lgkmcnt(0)" ::: "memory")

constexpr size_t MiB = 1u << 20;
constexpr size_t WS_CTL = 0, CTL_ZERO_BYTES = 65536;
constexpr size_t WS_SS = 1 * MiB;
constexpr size_t WS_C = 3 * MiB;
constexpr size_t WS_MEMB = 4 * MiB;
constexpr size_t WS_MEMKV = 5 * MiB;
constexpr size_t WS_SSM = 7 * MiB;
constexpr size_t WS_TOT = 7 * MiB + 65536;
constexpr size_t WS_WINA = 8 * MiB;
constexpr size_t WS_WCAT = 15 * MiB;
constexpr size_t WS_WINB1 = 19 * MiB;
constexpr size_t WS_WMEM = 21 * MiB;
constexpr size_t WS_WO = 25 * MiB;
constexpr size_t WS_W1 = 31 * MiB;
constexpr size_t WS_W2 = 63 * MiB;
constexpr size_t WS_HB = 96 * MiB;
constexpr size_t WS_KSH = 160 * MiB, WS_VSH = 192 * MiB;
constexpr size_t WS_A = 224 * MiB;
constexpr size_t WS_MERGED = WS_A + 112 * MiB;
constexpr size_t WS_END = 480 * MiB;
constexpr int CW_KMAX = 16;
constexpr int CW_BAR = 4096;
constexpr int LDS_BYTES = 147456, MISC_OFF = 131072 + 320;

namespace att {
constexpr int KP = 144, VP = 192, KBUF = 64 * KP, VBUF = 64 * VP, CBUF = 256, BUFSZ = KBUF + VBUF + CBUF, FLAG_OFF = 2 * BUFSZ;
constexpr float LOG2E = 1.4426950408889634f;
__device__ __forceinline__ unsigned cvtpk(float lo, float hi) { f32x2_t v = {lo, hi}; bf16x2_t b = __builtin_convertvector(v, bf16x2_t); return __builtin_bit_cast(unsigned, b); }
__device__ __forceinline__ float bf2f(short s) { return __uint_as_float(((unsigned)(unsigned short)s) << 16); }
typedef short v4i16_t __attribute__((ext_vector_type(4)));
__device__ __forceinline__ s16x4 vtr(const LAS unsigned char* p) { return __builtin_bit_cast(s16x4, __builtin_amdgcn_ds_read_tr16_b64_v4i16((LAS v4i16_t*)p)); }

template <int MODE, bool MASKED>
__device__ __forceinline__ void attn_tile(const LAS unsigned char* B, const bf16x8 (&qf)[4], f32x16& o0, f32x16& o1, float& R, float& mrun, float& lrun, bool& wdone,
                                          int s0, int tw, int trow, int hi, unsigned kro, unsigned vro, float qkb, float ct2) {
    f32x16 p0 = {0}, p1 = {0};
#pragma unroll
    for (int c = 0; c < 4; ++c) {
        const bf16x8 a0 = *(const LAS bf16x8*)(B + kro + c * 32);
        const bf16x8 a1 = *(const LAS bf16x8*)(B + kro + 32 * KP + c * 32);
        p0 = __builtin_amdgcn_mfma_f32_32x32x16_bf16(a0, qf[c], p0, 0, 0, 0);
        p1 = __builtin_amdgcn_mfma_f32_32x32x16_bf16(a1, qf[c], p1, 0, 0, 0);
    }
    s16x4 vf0[8], vf1[8];
#pragma unroll
    for (int kd = 0; kd < 8; ++kd) { vf0[kd] = vtr(B + vro + (16 * (kd >> 1)) * VP + 64 * (kd & 1)); vf1[kd] = vtr(B + vro + (16 * (kd >> 1) + 4) * VP + 64 * (kd & 1)); }
    float x[32];
    constexpr bool masked = MASKED;
    const int kb0 = s0 + 8 * hi;
    if (MODE == 0) {
        float om[32];
#pragma unroll
        for (int e = 0; e < 32; ++e) {
            const float ex = __builtin_amdgcn_exp2f((e < 16 ? p0[e & 15] : p1[e & 15]) * LOG2E);
            om[e] = __builtin_amdgcn_rcpf(1.0f + ex); x[e] = 1.0f - om[e];
        }
        if (masked) {
#pragma unroll
            for (int e = 0; e < 32; ++e) if (kb0 + 16 * (e >> 3) + (e & 7) >= trow) { om[e] = 1.0f; x[e] = 0.f; }
        }
        float tot[4], pt[4], off[4];
#pragma unroll
        for (int k = 0; k < 4; ++k) tot[k] = ((om[8 * k] * om[8 * k + 1]) * (om[8 * k + 2] * om[8 * k + 3])) * ((om[8 * k + 4] * om[8 * k + 5]) * (om[8 * k + 6] * om[8 * k + 7]));
#pragma unroll
        for (int k = 0; k < 4; ++k) pt[k] = __shfl_xor(tot[k], 32);
        float suf = R;
#pragma unroll
        for (int k = 3; k >= 0; --k) { off[k] = hi ? suf : suf * pt[k]; suf *= tot[k] * pt[k]; }
        R = suf;
#pragma unroll
        for (int k = 0; k < 4; ++k) {
            float r = off[k];
#pragma unroll
            for (int j = 7; j >= 0; --j) { x[8 * k + j] *= r; r *= om[8 * k + j]; }
        }
        wdone = __all(R < 1e-37f) != 0;
    } else {
        if (MODE == 1) {
#pragma unroll
            for (int k = 0; k < 4; ++k) {
                const LAS f32x4* cp4 = (const LAS f32x4*)(B + KBUF + VBUF + (16 * k + 8 * hi) * 4);
                const f32x4 ca = cp4[0], cb = cp4[1];
#pragma unroll
                for (int j = 0; j < 8; ++j) { const int e = 8 * k + j; x[e] = (e < 16 ? p0[e & 15] : p1[e & 15]) * LOG2E + (ct2 - (j < 4 ? ca[j & 3] : cb[j & 3])); }
            }
            if (masked) {
#pragma unroll
                for (int e = 0; e < 32; ++e) if (kb0 + 16 * (e >> 3) + (e & 7) > trow) x[e] = -1e30f;
            }
        } else {
#pragma unroll
            for (int e = 0; e < 32; ++e) x[e] = (e < 16 ? p0[e & 15] : p1[e & 15]) * LOG2E;
        }
        float mx = x[0];
#pragma unroll
        for (int e = 1; e < 32; ++e) mx = fmaxf(mx, x[e]);
        mx = fmaxf(mx, __shfl_xor(mx, 32));
        const float mnew = fmaxf(mrun, mx), sc = __builtin_amdgcn_exp2f(mrun - mnew);
        mrun = mnew;
        float rs = 0.f;
#pragma unroll
        for (int e = 0; e < 32; ++e) { x[e] = __builtin_amdgcn_exp2f(x[e] - mnew); rs += x[e]; }
        rs += __shfl_xor(rs, 32);
        lrun = lrun * sc + rs;
#pragma unroll
        for (int r = 0; r < 16; ++r) { o0[r] *= sc; o1[r] *= sc; }
        if (MODE == 1) {
            const float c0 = *(const LAS float*)(B + KBUF + VBUF);
            wdone = __all((qkb + (ct2 - c0) - mrun) < -50.f) != 0;
        }
    }
#pragma unroll
    for (int k = 0; k < 4; ++k) {
        u32x4 pw; pw.x = cvtpk(x[8 * k], x[8 * k + 1]); pw.y = cvtpk(x[8 * k + 2], x[8 * k + 3]); pw.z = cvtpk(x[8 * k + 4], x[8 * k + 5]); pw.w = cvtpk(x[8 * k + 6], x[8 * k + 7]);
        const bf16x8 pf = __builtin_bit_cast(bf16x8, pw);
#pragma unroll
        for (int db = 0; db < 2; ++db) {
            const s16x4 lo = vf0[2 * k + db], h4 = vf1[2 * k + db];
            const bf16x8 vf = {lo[0], lo[1], lo[2], lo[3], h4[0], h4[1], h4[2], h4[3]};
            if (db == 0) o0 = __builtin_amdgcn_mfma_f32_32x32x16_bf16(vf, pf, o0, 0, 0, 0);
            else o1 = __builtin_amdgcn_mfma_f32_32x32x16_bf16(vf, pf, o1, 0, 0, 0);
        }
    }
}

template <int MODE>
__device__ __forceinline__ void attn_unit(LAS unsigned char* lds, const bf16_t* Qp, int ldq, const bf16_t* Kp, int ldk, const bf16_t* Vp, int ldv, bf16_t* Op, int ldo,
                                          const float* cq, const float* ck, float kmax2, int q0, int itile0) {
    int tid_l = threadIdx.x; asm volatile("" : "+v"(tid_l));
    const int tid = tid_l, lane = tid & 63, wid = __builtin_amdgcn_readfirstlane(tid >> 6), r32 = lane & 31, hi = lane >> 5;
    const int tw = q0 + 32 * wid, trow = tw + r32;
    bf16x8 qf[4];
    { const bf16_t* qrow = Qp + (size_t)(32 * wid + r32) * ldq + 8 * hi;
#pragma unroll
      for (int c = 0; c < 4; ++c) qf[c] = *(const GAS bf16x8*)(qrow + 16 * c); }
    float qkb = 0.f, ct2 = 0.f;
    if (MODE == 1) {
        float s = 0.f;
#pragma unroll
        for (int c = 0; c < 4; ++c)
#pragma unroll
            for (int j = 0; j < 8; ++j) { const float v = bf2f(qf[c][j]); s += v * v; }
        s += __shfl_xor(s, 32);
        qkb = sqrtf(s) * kmax2 * 1.001f + 1e-3f;
        ct2 = *(const GAS float*)(cq + (size_t)(32 * wid + r32) * 8) * LOG2E;
    }
    const int srow = tid >> 3, sch = tid & 7;
    const bf16_t* kg = Kp + (size_t)srow * ldk + sch * 8; const bf16_t* vg = Vp + (size_t)srow * ldv + sch * 8;
    const unsigned kwo = srow * KP + sch * 16, vwo = KBUF + srow * VP + sch * 16;
    u32x4 krA, vrA, krB, vrB; float crA = 0.f, crB = 0.f;
#define ATT_LOAD(S, i) do { kr##S = *(const GAS u32x4*)(kg + (size_t)(i) * 64 * ldk); vr##S = *(const GAS u32x4*)(vg + (size_t)(i) * 64 * ldv); if (MODE == 1) cr##S = *(const GAS float*)(ck + (size_t)((i) * 64 + (tid & 63)) * 8) * LOG2E; } while (0)
#define ATT_STORE(S, b) do { *(LAS u32x4*)(lds + (b) * BUFSZ + kwo) = kr##S; *(LAS u32x4*)(lds + (b) * BUFSZ + vwo) = vr##S; if (MODE == 1 && tid < 64) *(LAS float*)(lds + (b) * BUFSZ + KBUF + VBUF + tid * 4) = cr##S; } while (0)
    f32x16 o0 = {0}, o1 = {0};
    float R = 1.f, mrun = -1e30f, lrun = 0.f;
    bool wdone = false;
    const int krow = (r32 & 0x13) | ((r32 & 4) << 1) | ((r32 & 8) >> 1);
    const unsigned kro = krow * KP + hi * 16;
    const unsigned vro = KBUF + (8 * hi + ((lane & 15) >> 2)) * VP + (16 * ((lane >> 4) & 1) + 4 * (lane & 3)) * 2;
    int i = itile0, cur = 0;
    ATT_LOAD(A, i); ATT_LOAD(B, (i > 0 ? i - 1 : 0));
    ATT_STORE(A, 0);
    asm volatile("s_waitcnt lgkmcnt(0)" ::: "memory"); __builtin_amdgcn_s_barrier(); asm volatile("" ::: "memory");
#define ATT_HALF(LS, SS) { \
        ATT_LOAD(LS, (i > 1 ? i - 2 : 0)); \
        if (!wdone && (MODE == 2 || 64 * i <= tw)) { \
            if (MODE != 2 && 64 * i + 64 > tw) attn_tile<MODE, true>(lds + cur * BUFSZ, qf, o0, o1, R, mrun, lrun, wdone, 64 * i, tw, trow, hi, kro, vro, qkb, ct2); \
            else attn_tile<MODE, false>(lds + cur * BUFSZ, qf, o0, o1, R, mrun, lrun, wdone, 64 * i, tw, trow, hi, kro, vro, qkb, ct2); } \
        if (i > 0) ATT_STORE(SS, cur ^ 1); \
        if (lane == 0) *(volatile LAS unsigned*)(lds + FLAG_OFF + (cur * 8 + wid) * 4) = wdone ? 0u : 1u; \
        asm volatile("s_waitcnt lgkmcnt(0)" ::: "memory"); __builtin_amdgcn_s_barrier(); asm volatile("" ::: "memory");     \
        if (i == 0) break; \
        { const LAS u32x4* fp = (const LAS u32x4*)(lds + FLAG_OFF + cur * 32); const u32x4 fa = fp[0], fb = fp[1]; \
          if (((fa.x | fa.y) | (fa.z | fa.w) | (fb.x | fb.y) | (fb.z | fb.w)) == 0u) break; } \
        --i; cur ^= 1; }
    for (;;) { ATT_HALF(A, B) ATT_HALF(B, A) }
#undef ATT_HALF
#undef ATT_LOAD
#undef ATT_STORE
    float inv = 1.f;
    if (MODE != 0) inv = 1.0f / lrun;
    bf16_t* orow = Op + (size_t)(32 * wid + r32) * ldo + 4 * hi;
#pragma unroll
    for (int g = 0; g < 4; ++g) {
        u32x2 w0; w0.x = cvtpk(o0[4 * g] * inv, o0[4 * g + 1] * inv); w0.y = cvtpk(o0[4 * g + 2] * inv, o0[4 * g + 3] * inv);
        u32x2 w1; w1.x = cvtpk(o1[4 * g] * inv, o1[4 * g + 1] * inv); w1.y = cvtpk(o1[4 * g + 2] * inv, o1[4 * g + 3] * inv);
        *(GAS u32x2*)(orow + 8 * g) = w0; *(GAS u32x2*)(orow + 32 + 8 * g) = w1;
    }
}
}

#define RLX_AGENT __ATOMIC_RELAXED, __HIP_MEMORY_SCOPE_AGENT
#define XB_TMO      128
#define XB_XCNT(j)  (256  + 64 * (j))
#define XB_XSUB(j)  (1280 + 64 * (j))
#define XB_XGEN(j)  (2304 + 64 * (j))
#define XB_TOP      3328
#define XB_TOPGEN   3392
#define XCD_BAR_WORDS 3456
#define XB_SPIN_CAP (1u << 18)

__device__ __forceinline__ unsigned xb_ld(unsigned* p)              { return __hip_atomic_load(p, __ATOMIC_RELAXED, __HIP_MEMORY_SCOPE_AGENT); }
__device__ __forceinline__ unsigned xb_add(unsigned* p, unsigned v) { return __hip_atomic_fetch_add(p, v, __ATOMIC_RELAXED, __HIP_MEMORY_SCOPE_AGENT); }
__device__ __forceinline__ unsigned xb_xcc_id() { return (unsigned)__builtin_amdgcn_s_getreg((3 << 11) | 20) & 0xFu; }
#define XB_SPIN(cond, bar) do { unsigned _sp = 0; while (cond) { __builtin_amdgcn_s_sleep(1); \
    if ((++_sp & 255u) == 0u) { if (xb_ld(&(bar)[XB_TMO])) break; if (_sp > XB_SPIN_CAP) { atomicAdd(&(bar)[XB_TMO], 1u); break; } } } } while (0)

struct XcdBarrier {
    unsigned* bar; unsigned x;
    volatile LAS unsigned* st;
};

__device__ __forceinline__ XcdBarrier xcd_barrier_post(unsigned* bar, volatile LAS unsigned* st) {
    XcdBarrier b; b.bar = bar; b.x = xb_xcc_id(); b.st = st;
    if (threadIdx.x == 0) (void)xb_add(&bar[XB_XCNT(b.x)], 1u);
    return b;
}
__device__ __forceinline__ void xcd_barrier_complete(unsigned* bar, unsigned x, unsigned& nloc, unsigned& nx) {
    const unsigned G = gridDim.x * gridDim.y * gridDim.z;
    unsigned sum, cnt, mine, sp = 0u;
    for (;;) {
        sum = 0u; cnt = 0u; mine = 0u;
#pragma unroll
        for (unsigned j = 0; j < 16; ++j) { const unsigned c = xb_ld(&bar[XB_XCNT(j)]); sum += c; cnt += (c > 0u) ? 1u : 0u; mine = (j == x) ? c : mine; }
        if (sum == G) break;
        __builtin_amdgcn_s_sleep(1);
        if ((++sp & 255u) == 0u) { if (xb_ld(&bar[XB_TMO])) break; if (sp > XB_SPIN_CAP) { atomicAdd(&bar[XB_TMO], 1u); break; } }
    }
    nloc = mine > 0u ? mine : 1u; nx = cnt > 0u ? cnt : 1u;
}

__device__ __forceinline__ void xcd_barrier(const XcdBarrier& b) {
    asm volatile("s_waitcnt vmcnt(0)" ::: "memory");
    __syncthreads();
    if (threadIdx.x == 0) {
        unsigned* bar = b.bar;
        __builtin_amdgcn_s_waitcnt(0);
        unsigned nloc = b.st[0], nx = b.st[1];
        if (nloc == 0u) { xcd_barrier_complete(bar, b.x, nloc, nx); b.st[0] = nloc; b.st[1] = nx; }
        const unsigned old = xb_add(&bar[XB_XSUB(b.x)], 1u);
        const unsigned gen = old / nloc;
        if (old + 1u == (gen + 1u) * nloc) {
            __builtin_amdgcn_fence(__ATOMIC_RELEASE, "agent");
            asm volatile("s_waitcnt vmcnt(0)" ::: "memory");
            const unsigned og = xb_add(&bar[XB_TOP], 1u);
            const unsigned tg = og / nx;
            if (og + 1u == (tg + 1u) * nx) xb_add(&bar[XB_TOPGEN], 1u);
            else XB_SPIN(xb_ld(&bar[XB_TOPGEN]) == tg, bar);
            __builtin_amdgcn_fence(__ATOMIC_ACQUIRE, "agent");
            xb_add(&bar[XB_XGEN(b.x)], 1u);
            asm volatile("s_waitcnt vmcnt(0)" ::: "memory");
        } else {
            XB_SPIN(xb_ld(&bar[XB_XGEN(b.x)]) == gen, bar);
            __builtin_amdgcn_fence(__ATOMIC_ACQUIRE, "agent");
            asm volatile("s_waitcnt vmcnt(0)" ::: "memory");
        }
    }
    __syncthreads();
}

__device__ __forceinline__ float wave_sum(float v) {
#pragma unroll
    for (int o = 1; o < 64; o <<= 1) v += __shfl_xor(v, o);
    return v;
}
__device__ __forceinline__ unsigned f2bf(float f) { unsigned u = __builtin_bit_cast(unsigned, f); return (u + 0x7fffu + ((u >> 16) & 1u)) >> 16; }
__device__ __forceinline__ unsigned pk2(float lo, float hi) { return f2bf(lo) | (f2bf(hi) << 16); }
__device__ __forceinline__ void conv_item(const float* W, int K, int N, const float* g, bf16_t* WT, int s_lo, int s_hi, LAS float* scr, int item, int lane) {
    const int nblk = (N + 31) / 32, kb = item / nblk, nb = item - kb * nblk, k0 = 64 * kb, n0 = 32 * nb;
    const int nl = n0 + (lane & 31);
    float v[32];
    const float* wp = W + (size_t)(k0 + (lane >> 5)) * N + nl;
#pragma unroll
    for (int i = 0; i < 32; ++i) v[i] = (nl < N) ? *(const GAS float*)(wp + (size_t)(2 * i) * N) : 0.f;
    const int c = lane & 7;
    f32x4 g0 = {1.f, 1.f, 1.f, 1.f}, g1 = {1.f, 1.f, 1.f, 1.f};
    if (g) { g0 = *(const GAS f32x4*)(g + k0 + 8 * c); g1 = *(const GAS f32x4*)(g + k0 + 8 * c + 4); }
#pragma unroll
    for (int i = 0; i < 32; ++i) scr[(2 * i + (lane >> 5)) * 33 + (lane & 31)] = v[i];
    LDS_WAIT(); asm volatile("" ::: "memory");
#pragma unroll
    for (int j = 0; j < 4; ++j) {
        const int n = (lane >> 3) + 8 * j; const LAS float* s = scr + (8 * c) * 33 + n;
        const float cs = ((n0 + n) < s_lo || (n0 + n) >= s_hi) ? 0.125f : 1.0f;
        u32x4 o; o.x = pk2(s[0 * 33] * g0[0] * cs, s[1 * 33] * g0[1] * cs); o.y = pk2(s[2 * 33] * g0[2] * cs, s[3 * 33] * g0[3] * cs);
        o.z = pk2(s[4 * 33] * g1[0] * cs, s[5 * 33] * g1[1] * cs); o.w = pk2(s[6 * 33] * g1[2] * cs, s[7 * 33] * g1[3] * cs);
        if (n0 + n < N) *(GAS u32x4*)(WT + (size_t)(n0 + n) * K + k0 + 8 * c) = o;
    }
    LDS_WAIT(); asm volatile("" ::: "memory");
}
__device__ __forceinline__ void rows2_to_bf16(const float* xrow, bf16_t* orow, float* ssrow, int lane) {
    const GAS f32x4* xr = (const GAS f32x4*)xrow + lane;
    f32x4 v[8]; float s0 = 0.f, s1 = 0.f;
#pragma unroll
    for (int j = 0; j < 8; ++j) v[j] = xr[64 * j];
#pragma unroll
    for (int j = 0; j < 4; ++j) { s0 += (v[j][0] * v[j][0] + v[j][1] * v[j][1]) + (v[j][2] * v[j][2] + v[j][3] * v[j][3]);
                                  s1 += (v[4 + j][0] * v[4 + j][0] + v[4 + j][1] * v[4 + j][1]) + (v[4 + j][2] * v[4 + j][2] + v[4 + j][3] * v[4 + j][3]); }
    GAS u32x2* o8 = (GAS u32x2*)orow + lane;
#pragma unroll
    for (int j = 0; j < 8; ++j) { u32x2 w; w.x = pk2(v[j][0], v[j][1]); w.y = pk2(v[j][2], v[j][3]); o8[64 * j] = w; }
    s0 = wave_sum(s0); s1 = wave_sum(s1);
    if (lane < 8) ssrow[lane] = (lane == 0) ? s0 : (lane == 4 ? s1 : 0.f);
}

struct Params { const float* in[15]; float* out; unsigned char* ws; };

__global__ void __launch_bounds__(NTHREADS, 2) yoco_fwd(Params P) {
    extern __shared__ __attribute__((aligned(16))) unsigned char lds_raw[];
    cg::grid_group grid = cg::this_grid();
    LAS unsigned char* lds = (LAS unsigned char*)lds_raw;
    const int G = gridDim.x, bx = blockIdx.x;
    for (int u = threadIdx.x; u < (LDS_BYTES - 131072) / 4; u += NTHREADS) ((LAS unsigned*)(lds + 131072))[u] = 0u;
    __syncthreads();
    const XcdBarrier xbar = xcd_barrier_post((unsigned*)(P.ws + WS_CTL) + CW_BAR, (volatile LAS unsigned*)(lds + MISC_OFF));
#define WSP(T, off) ((T*)(ws + (off)))
#define g_ctl WSP(unsigned, WS_CTL)
#define g_ss WSP(float, WS_SS)
#define g_cbuf WSP(float, WS_C)
#define g_ssm WSP(float, WS_SSM)
#define g_totb WSP(float, WS_TOT)
#define g_memb WSP(bf16_t, WS_MEMB)
#define g_memkv WSP(bf16_t, WS_MEMKV)
#define g_Wina WSP(bf16_t, WS_WINA)
#define g_Wcat WSP(bf16_t, WS_WCAT)
#define g_Winb1 WSP(bf16_t, WS_WINB1)
#define g_Wmem WSP(bf16_t, WS_WMEM)
#define g_Wo WSP(bf16_t, WS_WO)
#define g_W1 WSP(bf16_t, WS_W1)
#define g_W2 WSP(bf16_t, WS_W2)
#define g_hb WSP(bf16_t, WS_HB)
#define g_Ksh WSP(bf16_t, WS_KSH)
#define g_Vsh WSP(bf16_t, WS_VSH)
#define g_proj WSP(bf16_t, WS_A)
#define g_merged WSP(bf16_t, WS_MERGED)
#define g_hidden WSP(bf16_t, WS_A)
#define g_hout (P.out)

    {
        unsigned char* ws = P.ws;
        const int tid = threadIdx.x, lane = tid & 63, wave = __builtin_amdgcn_readfirstlane(tid >> 6);
        LAS float* scr = (LAS float*)(lds + wave * 16384);
        const int gw = bx * NWAVES + wave, NGW = G * NWAVES;
        for (int mi = 0; mi < 21; ++mi) {
            const float* W; const float* g = nullptr; bf16_t* WT; int K = 1024, N, s_lo = 0, s_hi = 0x7fffffff;
            if (mi < 2) { W = P.in[3] + (size_t)mi * 1024 * 1792; N = 1792; g = P.in[2] + mi * 1024; WT = g_Wina + (size_t)mi * 1792 * 1024; s_lo = 512; s_hi = 1536; }
            else if (mi == 2) { W = P.in[4]; N = 768; g = P.in[2] + 2 * 1024; WT = g_Wcat; s_lo = 768; }
            else if (mi == 3) { W = P.in[12]; N = 1032; g = P.in[11]; WT = g_Wcat + (size_t)768 * 1024; }
            else if (mi == 4) { W = P.in[4] + (size_t)1024 * 768; N = 768; g = P.in[2] + 3 * 1024; WT = g_Winb1; s_lo = 768; }
            else if (mi < 9) { const int l = mi - 5; W = P.in[5] + (size_t)l * 1024 * 512; N = 512; g = P.in[6] + l * 1024; WT = g_Wmem + (size_t)l * 512 * 1024; }
            else if (mi < 13) { const int l = mi - 9; W = P.in[7] + (size_t)l * 768 * 1024; K = 768; N = 1024; WT = g_Wo + (size_t)l * 1024 * 768; }
            else if (mi < 17) { const int l = mi - 13; W = P.in[9] + (size_t)l * 1024 * 4096; N = 4096; g = P.in[8] + l * 1024; WT = g_W1 + (size_t)l * 4096 * 1024; }
            else { const int l = mi - 17; W = P.in[10] + (size_t)l * 4096 * 1024; K = 4096; N = 1024; WT = g_W2 + (size_t)l * 1024 * 4096; }
            const int nitems = (K / 64) * ((N + 31) / 32);
            for (int it = gw; it < nitems; it += NGW) conv_item(W, K, N, g, WT, s_lo, s_hi, scr, it, lane);
        }
        { u32x4* z = (u32x4*)(g_Wcat + (size_t)1800 * 1024); const int nz = 248 * 1024 * 2 / 16; const u32x4 zero = {0u, 0u, 0u, 0u};
          for (int e = gw * 64 + lane; e < nz; e += NGW * 64) z[e] = zero; }
        for (int m = 2 * gw; m < MROWS; m += 2 * NGW) rows2_to_bf16(P.in[0] + (size_t)m * 1024, g_hb + (size_t)m * 1024, g_ss + (size_t)m * 4, lane);
        for (int m = 2 * gw; m < MEMROWS; m += 2 * NGW) rows2_to_bf16(P.in[1] + (size_t)m * 1024, g_memb + (size_t)m * 1024, g_ssm + (size_t)m * 4, lane);
    }
    grid.sync();

    for (int l = 0; l < 4; ++l) {
        for (int sub = 0; sub < 5; ++sub) {
            unsigned char* ws = P.ws; asm volatile("" : "+s"(ws));
            int tid = threadIdx.x; asm volatile("" : "+v"(tid)); const int lane = tid & 63;
            switch (sub) {
            case 0: case 3: {
                for (int pass = (l == 0 && sub == 0) ? 0 : 1; pass < 2; ++pass) {
                    pg8::Gemm g; pg8::EpiProj E; E.ss = g_ss; E.act = 0; E.cat = 0; E.Ksh = g_Ksh; E.Vsh = g_Vsh; E.flog = g_cbuf; int cidx = bx;
                    if (pass == 0) { g.A = g_memb; g.Bt = g_Wmem; g.M = MEMROWS; g.N = 2048; g.K = 1024; E.ss = g_ssm; E.O = g_memkv; E.ldc = 2048; cidx = (bx + G / 2) % G; }
                    else if (sub == 3) { g.A = g_hb; g.Bt = g_W1 + (size_t)l * 4096 * 1024; g.M = MROWS; g.N = DFF; g.K = 1024; E.O = g_hidden; E.ldc = DFF; E.act = 1; }
                    else if (l < 2) { g.A = g_hb; g.Bt = g_Wina + (size_t)l * 1792 * 1024; g.M = MROWS; g.N = 1792; g.K = 1024; E.O = g_proj; E.ldc = 1792; }
                    else if (l == 2) { g.A = g_hb; g.Bt = g_Wcat; g.M = MROWS; g.N = 2048; g.K = 1024; E.O = g_proj; E.ldc = 768; E.cat = 1; }
                    else { g.A = g_hb; g.Bt = g_Winb1; g.M = MROWS; g.N = 768; g.K = 1024; E.O = g_proj; E.ldc = 768; }
                    pg8::StaticOrder S; S.init(g.M, g.N, G, cidx);
                    pg8::gemm_phase<pg8::EpiProj, pg8::StaticOrder, true, true>(lds, g, S, E);
                }
            } break;
            case 1: {
                if (l == 2) {
                    LAS float* sb = (LAS float*)lds;
                    for (int ch = bx; ch < MROWS / 128; ch += G) {
                        const int r0 = ch * 128;
                        for (int e = tid; e < 1024; e += NTHREADS) {
                            const float f = g_cbuf[(size_t)r0 * 8 + e] + P.in[13][e & 7];
                            sb[e] = -(fmaxf(-f, 0.f) + log1pf(expf(-fabsf(f))));
                        }
                        __syncthreads();
                        if (tid < 8) { float a = 0.f; for (int r = 0; r < 128; ++r) { a += sb[r * 8 + tid]; sb[r * 8 + tid] = a; } g_totb[ch * 8 + tid] = a; }
                        __syncthreads();
                        for (int e = tid; e < 1024; e += NTHREADS) g_cbuf[(size_t)r0 * 8 + e] = sb[e];
                        float mx = 0.f;
                        for (int e = tid; e < 1024; e += NTHREADS) {
                            const bf16x8* kp = (const bf16x8*)(g_Ksh + (size_t)(r0 + (e >> 3)) * 512 + (e & 7) * 64); float s = 0.f;
#pragma unroll
                            for (int c = 0; c < 8; ++c) { const bf16x8 v = kp[c];
#pragma unroll
                                for (int j = 0; j < 8; ++j) { const float f = att::bf2f(v[j]); s += f * f; } }
                            mx = fmaxf(mx, s);
                        }
                        mx = fmaxf(mx, __shfl_xor(mx, 8)); mx = fmaxf(mx, __shfl_xor(mx, 16)); mx = fmaxf(mx, __shfl_xor(mx, 32));
                        if (lane < 8) atomicMax(g_ctl + CW_KMAX + (r0 >> 14) * 8 + lane, __float_as_uint(mx));
                        __syncthreads();
                    }
                    xcd_barrier(xbar);
                    for (int ch = bx; ch < MROWS / 128; ch += G) {
                        const int r0 = ch * 128, c0 = ch & ~127;
                        {
                          const int hd8 = tid & 7, j = tid >> 3; float a = 0.f;
                          if (c0 + j < ch) a += *(const GAS float*)(g_totb + (size_t)(c0 + j) * 8 + hd8);
                          if (c0 + 64 + j < ch) a += *(const GAS float*)(g_totb + (size_t)(c0 + 64 + j) * 8 + hd8);
                          a += __shfl_xor(a, 8); a += __shfl_xor(a, 16); a += __shfl_xor(a, 32);
                          if (lane < 8) sb[16 + (tid >> 6) * 8 + lane] = a;
                          __syncthreads();
                          if (tid < 8) { float s = 0.f;
#pragma unroll
                              for (int w = 0; w < 8; ++w) s += sb[16 + w * 8 + tid];
                              sb[tid] = s; }
                        }
                        __syncthreads();
                        for (int e = tid; e < 1024; e += NTHREADS) g_cbuf[(size_t)r0 * 8 + e] += sb[e & 7];
                        __syncthreads();
                    }
                    xcd_barrier(xbar);
                }
                const int ldp = (l < 2) ? 1792 : 768;
                for (int u = bx; u < 1536; u += G) {
                    if (u < 1024) {
                        const int cu = u & 255, kk = u >> 8, bh = (cu & 7) * 2 + (cu >> 7), qb = ((cu >> 3) & 15) * 4 + kk, hd = bh & 7, b = bh >> 3, q0 = 256 * qb;     const size_t rq = (size_t)b * SEQ + q0, rk = (size_t)b * SEQ;
                        if (l < 2) att::attn_unit<0>(lds, g_proj + rq * 1792 + hd * 64, 1792, g_proj + rk * 1792 + 512 + hd * 64, 1792, g_proj + rk * 1792 + 1024 + hd * 64, 1792,
                                                     g_merged + rq * 768 + hd * 64, 768, nullptr, nullptr, 0.f, q0, (q0 >> 6) + 3);
                        else { const float kmax2 = sqrtf(__uint_as_float(g_ctl[CW_KMAX + b * 8 + hd])) * att::LOG2E;
                               att::attn_unit<1>(lds, g_proj + rq * 768 + hd * 64, 768, g_Ksh + rk * 512 + hd * 64, 512, g_Vsh + rk * 512 + hd * 64, 512,
                                                 g_merged + rq * 768 + hd * 64, 768, g_cbuf + rq * 8 + hd, g_cbuf + rk * 8 + hd, kmax2, q0, (q0 >> 6) + 3); }
                    } else {
                        const int u2 = u - 1024, rb = u2 & 127, hm = u2 >> 7; const size_t rq = (size_t)rb * 256; const int b = (int)(rq >> 14);
                        const bf16_t* qp = g_proj + rq * ldp + ((l < 2) ? 1536 : 512) + hm * 64;
                        const bf16_t* kp = g_memkv + (size_t)(b * NMEM) * 2048 + l * 512 + hm * 64;
                        att::attn_unit<2>(lds, qp, ldp, kp, 2048, kp + 256, 2048, g_merged + rq * 768 + 512 + hm * 64, 768, nullptr, nullptr, 0.f, 0, 3);
                    }
                }
            } break;
            default: {
                pg8::Gemm g; g.M = MROWS; g.N = 1024;
                if (sub == 2) { g.A = g_merged; g.Bt = g_Wo + (size_t)l * 1024 * 768; g.K = 768; } else { g.A = g_hidden; g.Bt = g_W2 + (size_t)l * 1024 * 4096; g.K = DFF; }
                pg8::EpiRes E; E.hb = g_hb; E.ss = g_ss; E.red = (LAS float*)(lds + 131072 + 1024);
                pg8::StaticOrder S; S.init(g.M, g.N, G, bx);
                pg8::gemm_phase<pg8::EpiRes, pg8::StaticOrder, true, true>(lds, g, S, E);
            } break;
            }
            xcd_barrier(xbar);
        }
    }
    {
        unsigned char* ws = P.ws; asm volatile("" : "+s"(ws));
        int tid_l = threadIdx.x; asm volatile("" : "+v"(tid_l));
        const int tid = tid_l, lane = tid & 63, wave = __builtin_amdgcn_readfirstlane(tid >> 6);
        const int gw = bx * NWAVES + wave, NGW = G * NWAVES;
        const f32x4* gp = (const f32x4*)P.in[14] + lane;
        f32x4 gv[4];
#pragma unroll
        for (int j = 0; j < 4; ++j) gv[j] = gp[64 * j];
        for (int m = gw; m < MROWS; m += NGW) {
            float s = (lane < 4) ? *(const GAS float*)(g_ss + (size_t)m * 4 + lane) : 0.f;
            s = wave_sum(s);
            const float rs = 1.0f / sqrtf(s * (1.0f / 1024.0f) + pg8::RMS_EPS);
            const GAS u32x2* hr = (const GAS u32x2*)(g_hb + (size_t)m * 1024) + lane;
            GAS f32x4* xr = (GAS f32x4*)(g_hout + (size_t)m * 1024) + lane;
#pragma unroll
            for (int j = 0; j < 4; ++j) { const u32x2 w = hr[64 * j]; const f32x4 v = {pg8::bf_lo(w.x), pg8::bf_hi(w.x), pg8::bf_lo(w.y), pg8::bf_hi(w.y)}; xr[64 * j] = v * rs * gv[j]; }
        }
    }
}

extern "C" void kernel_launch(void* const* d_in, const int* in_sizes, int n_in, void* d_out, int out_size, void* d_ws, size_t ws_size, hipStream_t stream) {
    static int grid = 0;
    if (grid == 0) {
        if (n_in != 15 || in_sizes[0] != MROWS * D_MODEL || out_size != MROWS * D_MODEL || ws_size < WS_END) {
            fprintf(stderr, "kernel_launch: unexpected shapes / workspace (n_in %d, in0 %d, out %d, ws %zu < %zu); nothing launched\n", n_in, n_in > 0 ? in_sizes[0] : -1, out_size, ws_size, (size_t)WS_END);
            grid = -1; return;
        }
        int dev = 0, cus = 0, per_cu = 0;
        if (hipGetDevice(&dev) != hipSuccess || hipDeviceGetAttribute(&cus, hipDeviceAttributeMultiprocessorCount, dev) != hipSuccess) { fprintf(stderr, "kernel_launch: device query failed\n"); grid = -1; return; }
        if (hipFuncSetAttribute((const void*)yoco_fwd, hipFuncAttributeMaxDynamicSharedMemorySize, LDS_BYTES) != hipSuccess) { fprintf(stderr, "kernel_launch: hipFuncSetAttribute failed\n"); grid = -1; return; }
        if (hipOccupancyMaxActiveBlocksPerMultiprocessor(&per_cu, (const void*)yoco_fwd, NTHREADS, LDS_BYTES) != hipSuccess || per_cu < 1) { fprintf(stderr, "kernel_launch: occupancy query says %d\n", per_cu); per_cu = 1; }
        (void)hipGetLastError();
        grid = cus * 1;
    }
    if (grid < 0) return;
    (void)hipMemsetAsync((char*)d_ws + WS_CTL, 0, CTL_ZERO_BYTES, stream);
    Params p{};
    for (int i = 0; i < 15; ++i) p.in[i] = (const float*)d_in[i];
    p.out = (float*)d_out; p.ws = (unsigned char*)d_ws;
    void* args[] = {&p};
    hipError_t e = hipLaunchCooperativeKernel((const void*)yoco_fwd, dim3(grid), dim3(NTHREADS), args, LDS_BYTES, stream);
    if (e != hipSuccess) fprintf(stderr, "kernel_launch: cooperative launch failed: %s (grid %d)\n", hipGetErrorString(e), grid);
}
```

```cpp
#include <hip/hip_runtime.h>
#include <hip/hip_cooperative_groups.h>
#include <cstdio>
#include <cstdint>
namespace cg = cooperative_groups;
namespace pg8 {
#define PG8_LAS __attribute__((address_space(3)))
typedef unsigned short bf16_t;
typedef short bf16x8 __attribute__((ext_vector_type(8)));
typedef float f32x4 __attribute__((ext_vector_type(4)));
typedef unsigned u32x4 __attribute__((ext_vector_type(4)));
constexpr int BM = 256, BK = 64, HALF = 128, HTB = HALF * BK * 2  , STAGE_BYTES = 8 * HTB, NXCD = 8, WGM = 8;

__host__ __device__ __forceinline__ int lds_byte(int r, int c) { const int st = (r >> 4) * 2 + (c >> 5), rr = r & 15, cc = c & 31, ob = rr * 64 + cc * 2; return st * 1024 + (ob ^ (((ob >> 9) & 1) << 5)); }
__host__ __device__ __forceinline__ void stage_rc(int b, int& R, int& C) { const int st = b / 1024, sb = b % 1024, swz = sb ^ (((sb >> 9) & 1) << 5); R = (st >> 1) * 16 + swz / 64; C = (st & 1) * 32 + (swz % 64) / 2; }
__host__ __device__ __forceinline__ int perm32(int rho) { const int n = rho >> 4, i = rho & 15; return 8 * (i >> 2) + 4 * n + (i & 3); }

struct Unit { int pm, pn; };
struct Gemm { const bf16_t* A; const bf16_t* Bt; int M, N, K; };

struct StaticOrder {
    int nM, nN, nwg, G, c;
    __host__ __device__ void init(int M, int N, int G_, int c_) { nM = M / BM; nN = N / BM; nwg = nM * nN; G = G_; c = c_; }
    __host__ __device__ bool next(int i, Unit& u) const {
        const long L = (long)i * G + c; if (L >= nwg) return false;
        int wgid = (int)L; { const int q = nwg / NXCD, r = nwg % NXCD, xcd = wgid % NXCD, off = wgid / NXCD; wgid = (xcd < r ? xcd * (q + 1) : r * (q + 1) + (xcd - r) * q) + off; }
        const int nig = WGM * nN, gid = wgid / nig, fm = gid * WGM, gsz = (nM - fm) < WGM ? (nM - fm) : WGM;
        u.pm = fm + ((wgid % nig) % gsz); u.pn = (wgid % nig) / gsz; return true;
    }
    __device__ __forceinline__ void a_ready(const Unit&) const {}
    __device__ __forceinline__ void done(const Unit&) const {}
};
__device__ __forceinline__ unsigned cvt_pk_bf16(float lo, float hi) { unsigned r; asm volatile("v_cvt_pk_bf16_f32 %0, %1, %2" : "=v"(r) : "v"(lo), "v"(hi)); return r; }
constexpr float RMS_EPS = 1e-6f;
typedef unsigned u32x2 __attribute__((ext_vector_type(2)));
#define PG8_GAS __attribute__((address_space(1)))
struct EpiProj {
    static constexpr bool PERM = true, AFTER_DRAIN = false;
    const float* ss; bf16_t* O; int ldc; int act; int cat; bf16_t* Ksh; bf16_t* Vsh; float* flog;
    __device__ __forceinline__ void operator()(const f32x4 (&acc)[2][2][4][2], const Unit& u, int wr, int wc, int fr, int fq) const {
        const int row0 = u.pm * BM + wr * 64 + fr;
        bf16_t* base = O; int ld = ldc; int colt = u.pn * BM; int kind = 0;
        if (cat) { if (u.pn >= 7) kind = 2; else if (u.pn >= 5) { base = Vsh; ld = 512; colt = (u.pn - 5) * BM; } else if (u.pn >= 3) { base = Ksh; ld = 512; colt = (u.pn - 3) * BM; } }
        const int col0 = colt + wc * 32 + 8 * fq;
        f32x4 sv[2][4];
#pragma unroll
        for (int ai = 0; ai < 2; ++ai)
#pragma unroll
            for (int m = 0; m < 4; ++m) sv[ai][m] = *(const PG8_GAS f32x4*)(ss + (size_t)(row0 + ai * HALF + m * 16) * 4);
#pragma unroll
        for (int ai = 0; ai < 2; ++ai)
#pragma unroll
            for (int m = 0; m < 4; ++m) {
                const int row = row0 + ai * HALF + m * 16;
                const f32x4 sa = sv[ai][m];
                const float t = (sa[0] + sa[1]) + (sa[2] + sa[3]);
                const float rs = __builtin_amdgcn_rsqf(t * (1.0f / 1024.0f) + RMS_EPS);
                if (kind == 2) {
                    if (wc == 0 && fq == 0) { const f32x4 v0 = acc[ai][0][m][0] * rs, v1 = acc[ai][0][m][1] * rs; *(PG8_GAS f32x4*)(flog + (size_t)row * 8) = v0; *(PG8_GAS f32x4*)(flog + (size_t)row * 8 + 4) = v1; }
                } else {
                    bf16_t* rowp = base + (size_t)row * ld + col0;
#pragma unroll
                    for (int bj = 0; bj < 2; ++bj) {
                        f32x4 v0 = acc[ai][bj][m][0] * rs, v1 = acc[ai][bj][m][1] * rs;
                        if (act) {
#pragma unroll
                            for (int j = 0; j < 4; ++j) { const float a = fmaxf(v0[j], 0.f), b = fmaxf(v1[j], 0.f); v0[j] = a * a; v1[j] = b * b; }
                        }
                        u32x4 w; w.x = cvt_pk_bf16(v0[0], v0[1]); w.y = cvt_pk_bf16(v0[2], v0[3]); w.z = cvt_pk_bf16(v1[0], v1[1]); w.w = cvt_pk_bf16(v1[2], v1[3]);
                        *(PG8_GAS u32x4*)(rowp + bj * HALF) = w;
                    }
                }
            }
    }
};
__device__ __forceinline__ float bf_lo(unsigned w) { return __uint_as_float(w << 16); }
__device__ __forceinline__ float bf_hi(unsigned w) { return __uint_as_float(w & 0xffff0000u); }
struct EpiRes {
    static constexpr bool PERM = false, AFTER_DRAIN = false;
    bf16_t* hb; float* ss; PG8_LAS float* red;
    __device__ __forceinline__ void operator()(const f32x4 (&acc)[2][2][4][2], const Unit& u, int wr, int wc, int fr, int fq) const {
        const int col0 = u.pn * BM + wc * 32 + 4 * fq;
#pragma unroll
        for (int ai = 0; ai < 2; ++ai) {
            u32x2 b[4][2][2];
#pragma unroll
            for (int m = 0; m < 4; ++m) {
                const size_t off = (size_t)(u.pm * BM + ai * HALF + wr * 64 + m * 16 + fr) * 1024 + col0;
#pragma unroll
                for (int bj = 0; bj < 2; ++bj)
#pragma unroll
                    for (int n = 0; n < 2; ++n) b[m][bj][n] = *(const PG8_GAS u32x2*)(hb + off + bj * HALF + n * 16);
            }
#pragma unroll
            for (int m = 0; m < 4; ++m) {
                const int rt = ai * HALF + wr * 64 + m * 16 + fr; const size_t off = (size_t)(u.pm * BM + rt) * 1024 + col0; float q = 0.f;
#pragma unroll
                for (int bj = 0; bj < 2; ++bj)
#pragma unroll
                    for (int n = 0; n < 2; ++n) {
                        const f32x4 a = acc[ai][bj][m][n]; const u32x2 bb = b[m][bj][n];
                        u32x2 w; w.x = cvt_pk_bf16(bf_lo(bb.x) + a[0], bf_hi(bb.x) + a[1]); w.y = cvt_pk_bf16(bf_lo(bb.y) + a[2], bf_hi(bb.y) + a[3]);
                        *(PG8_GAS u32x2*)(hb + off + bj * HALF + n * 16) = w;
                        const float o0 = bf_lo(w.x), o1 = bf_hi(w.x), o2 = bf_lo(w.y), o3 = bf_hi(w.y);
                        q += (o0 * o0 + o1 * o1) + (o2 * o2 + o3 * o3);
                    }
                q += __shfl_xor(q, 16); q += __shfl_xor(q, 32);
                if (fq == 0) red[rt * 4 + wc] = q;
            }
            asm volatile("" ::: "memory");
        }
        asm volatile("s_waitcnt lgkmcnt(0)" ::: "memory"); __builtin_amdgcn_s_barrier(); asm volatile("" ::: "memory");
        int t = threadIdx.x; asm volatile("" : "+v"(t));
        if (t < 256) { const f32x4 v = *(const PG8_LAS f32x4*)(red + t * 4); *(PG8_GAS float*)(ss + (size_t)(u.pm * BM + t) * 4 + u.pn) = (v[0] + v[1]) + (v[2] + v[3]); }
    }
};
template <class Epi, class Sched, bool ALIGN_EPI = false, bool SP2 = false>
__device__ __forceinline__ void gemm_phase(PG8_LAS unsigned char* lds, const Gemm g, const Sched& S, const Epi& E) {
    int tid_l = threadIdx.x; asm volatile("" : "+v"(tid_l));
    const int tid = tid_l, wid = __builtin_amdgcn_readfirstlane(tid >> 6), lane = tid & 63, wr = wid >> 2, wc = wid & 3, fr = lane & 15, fq = lane >> 4;
    const int K = g.K, nt = K / BK;
    unsigned voffA[2], voffB[2];
#pragma unroll
    for (int i = 0; i < 2; ++i) { int R, C; stage_rc(tid * 16 + i * 8192, R, C); const int Rb = Epi::PERM ? ((R & ~31) + perm32(R & 31)) : R;
        voffA[i] = (unsigned)(R * K + C) * 2u; voffB[i] = (unsigned)(Rb * K + C) * 2u; }
    const size_t kstep = (size_t)(BK * 2);
    const size_t hstep = (size_t)HALF * K * 2;
    const size_t tstep = 2 * hstep;
    const unsigned ldsw = (unsigned)wid * 1024u;
    const int aoff = lds_byte(wr * 64 + fr, fq * 8), boff = lds_byte(wc * 32 + fr, fq * 8);
#define PG8_SA(b, h) (((b) * 2 + (h)) * HTB)
#define PG8_SB(b, h) ((4 + (b) * 2 + (h)) * HTB)
#define PG8_STAGE(bufoff, gbase, voff) do { _Pragma("unroll") for (int _i = 0; _i < 2; ++_i) \
        __builtin_amdgcn_global_load_lds((const unsigned*)((const char*)(gbase) + (voff)[_i]), (PG8_LAS unsigned*)(lds + (bufoff) + ldsw + _i * 8192), 16, 0, 0); } while (0)
#define PG8_LDA(dst, b, h) do { _Pragma("unroll") for (int m = 0; m < 4; ++m) _Pragma("unroll") for (int k = 0; k < 2; ++k) dst[m][k] = *(const PG8_LAS bf16x8*)(lds + PG8_SA(b, h) + aoff + m * 2048 + k * 1024); } while (0)
#define PG8_LDB(dst, b, h) do { _Pragma("unroll") for (int n = 0; n < 2; ++n) _Pragma("unroll") for (int k = 0; k < 2; ++k) dst[n][k] = *(const PG8_LAS bf16x8*)(lds + PG8_SB(b, h) + boff + n * 2048 + k * 1024); } while (0)
#define PG8_MMA(ai, bj, At, Bt) do { __builtin_amdgcn_s_setprio(1); _Pragma("unroll") for (int m = 0; m < 4; ++m) _Pragma("unroll") for (int n = 0; n < 2; ++n) _Pragma("unroll") for (int k = 0; k < 2; ++k) \
        acc[ai][bj][m][n] = __builtin_amdgcn_mfma_f32_16x16x32_bf16(Bt[n][k], At[m][k], acc[ai][bj][m][n], 0, 0, 0); __builtin_amdgcn_s_setprio(0); } while (0)
#define PG8_WAIT_V(n) asm volatile("s_waitcnt vmcnt(" #n ")" ::: "memory")
#define PG8_WAIT_L(n) asm volatile("s_waitcnt lgkmcnt(" #n ")" ::: "memory")
#define PG8_BAR __builtin_amdgcn_s_barrier()
#define PG8_SCHED __builtin_amdgcn_sched_barrier(0)
    Unit cur, nxt; int ui = 0;
    if (!S.next(0, cur)) return;
    f32x4 acc[2][2][4][2];
#pragma unroll
    for (int a = 0; a < 2; ++a)
#pragma unroll
        for (int b = 0; b < 2; ++b)
#pragma unroll
            for (int m = 0; m < 4; ++m)
#pragma unroll
                for (int n = 0; n < 2; ++n) acc[a][b][m][n] = (f32x4){0.f, 0.f, 0.f, 0.f};
    bf16x8 At[4][2], B0[2][2], B1[2][2];
    const char* cA = (const char*)g.A + (size_t)cur.pm * tstep; const char* cB = (const char*)g.Bt + (size_t)cur.pn * tstep;
    S.a_ready(cur);
    if constexpr (SP2) {
        PG8_STAGE(PG8_SB(0, 0), cB, voffB); PG8_STAGE(PG8_SB(0, 1), cB + hstep, voffB); PG8_STAGE(PG8_SA(0, 0), cA, voffA); PG8_STAGE(PG8_SA(0, 1), cA + hstep, voffA);
        if (wr == 1) PG8_BAR;
        PG8_WAIT_V(2); PG8_BAR;
        PG8_STAGE(PG8_SB(1, 0), cB + kstep, voffB); PG8_STAGE(PG8_SA(1, 0), cA + kstep, voffA); PG8_STAGE(PG8_SB(1, 1), cB + hstep + kstep, voffB);
        PG8_WAIT_V(6); PG8_BAR;
    } else {
        PG8_STAGE(PG8_SB(0, 0), cB, voffB); PG8_STAGE(PG8_SA(0, 0), cA, voffA); PG8_STAGE(PG8_SB(0, 1), cB + hstep, voffB); PG8_STAGE(PG8_SA(0, 1), cA + hstep, voffA);
        if (wr == 1) PG8_BAR;
        PG8_WAIT_V(4); PG8_BAR;
        PG8_STAGE(PG8_SB(1, 0), cB + kstep, voffB); PG8_STAGE(PG8_SA(1, 0), cA + kstep, voffA); PG8_STAGE(PG8_SB(1, 1), cB + hstep + kstep, voffB);
        PG8_WAIT_V(6); PG8_BAR;
    }
    for (;;) {
        const bool has_next = S.next(ui + 1, nxt);
        const char* nA = has_next ? (const char*)g.A + (size_t)nxt.pm * tstep : cA; const char* nB = has_next ? (const char*)g.Bt + (size_t)nxt.pn * tstep : cB;
        for (int t = 0; t < nt; t += 2) {
            const bool last = (t == nt - 2);
            const char* a1 = cA + (size_t)(t + 1) * kstep;
            const char* a2 = last ? nA : cA + (size_t)(t + 2) * kstep; const char* b2 = last ? nB : cB + (size_t)(t + 2) * kstep;
            const char* a3 = a2 + kstep; const char* b3 = b2 + kstep;
            if (last && has_next) S.a_ready(nxt);
            if constexpr (SP2) {
            PG8_LDB(B0, 0, 0); PG8_LDB(B1, 0, 1); PG8_SCHED; PG8_LDA(At, 0, 0); PG8_STAGE(PG8_SA(1, 1), a1 + hstep, voffA);
            PG8_WAIT_V(8); PG8_WAIT_L(0); PG8_BAR; PG8_MMA(0, 0, At, B0); PG8_MMA(0, 1, At, B1); PG8_BAR; PG8_SCHED;
            PG8_LDA(At, 0, 1); PG8_STAGE(PG8_SB(0, 0), b2, voffB); PG8_STAGE(PG8_SB(0, 1), b2 + hstep, voffB); PG8_STAGE(PG8_SA(0, 0), a2, voffA);
            PG8_WAIT_V(8); PG8_WAIT_L(0); PG8_BAR; PG8_MMA(1, 0, At, B0); PG8_MMA(1, 1, At, B1); PG8_BAR; PG8_SCHED;
            PG8_LDB(B0, 1, 0); PG8_LDB(B1, 1, 1); PG8_SCHED; PG8_LDA(At, 1, 0); PG8_STAGE(PG8_SA(0, 1), a2 + hstep, voffA);
            PG8_WAIT_V(8); PG8_WAIT_L(0); PG8_BAR; PG8_MMA(0, 0, At, B0); PG8_MMA(0, 1, At, B1); PG8_BAR; PG8_SCHED;
            PG8_LDA(At, 1, 1); PG8_STAGE(PG8_SB(1, 0), b3, voffB); PG8_STAGE(PG8_SB(1, 1), b3 + hstep, voffB); PG8_STAGE(PG8_SA(1, 0), a3, voffA);
            PG8_WAIT_V(8); PG8_WAIT_L(0); PG8_BAR; PG8_MMA(1, 0, At, B0); PG8_MMA(1, 1, At, B1); PG8_BAR; PG8_SCHED;
            } else {
            PG8_LDB(B0, 0, 0); PG8_SCHED; PG8_LDA(At, 0, 0); PG8_STAGE(PG8_SA(1, 1), a1 + hstep, voffA);
            PG8_WAIT_L(8); PG8_BAR; PG8_WAIT_L(0); PG8_MMA(0, 0, At, B0); PG8_BAR; PG8_SCHED;
            PG8_LDB(B1, 0, 1); PG8_STAGE(PG8_SB(0, 0), b2, voffB);
            PG8_BAR; PG8_WAIT_L(0); PG8_MMA(0, 1, At, B1); PG8_BAR;
            PG8_LDA(At, 0, 1); PG8_STAGE(PG8_SA(0, 0), a2, voffA);
            PG8_BAR; PG8_WAIT_L(0); PG8_MMA(1, 0, At, B0); PG8_BAR; PG8_SCHED;
            PG8_STAGE(PG8_SB(0, 1), b2 + hstep, voffB);
            PG8_WAIT_V(6); PG8_BAR; PG8_MMA(1, 1, At, B1); PG8_BAR;
            PG8_LDB(B0, 1, 0); PG8_SCHED; PG8_LDA(At, 1, 0); PG8_STAGE(PG8_SA(0, 1), a2 + hstep, voffA);
            PG8_WAIT_L(8); PG8_BAR; PG8_WAIT_L(0); PG8_MMA(0, 0, At, B0); PG8_BAR; PG8_SCHED;
            PG8_LDB(B1, 1, 1); PG8_STAGE(PG8_SB(1, 0), b3, voffB);
            PG8_BAR; PG8_WAIT_L(0); PG8_MMA(0, 1, At, B1); PG8_BAR;
            PG8_LDA(At, 1, 1); PG8_STAGE(PG8_SA(1, 0), a3, voffA);
            PG8_BAR; PG8_WAIT_L(0); PG8_MMA(1, 0, At, B0); PG8_BAR; PG8_SCHED;
            PG8_STAGE(PG8_SB(1, 1), b3 + hstep, voffB);
            PG8_WAIT_V(6); PG8_BAR; PG8_MMA(1, 1, At, B1); PG8_BAR;
            }
        }
        if constexpr (ALIGN_EPI) { if (wr == 0) PG8_BAR; }
        if constexpr (!Epi::AFTER_DRAIN) { E(acc, cur, wr, wc, fr, fq); S.done(cur); }
        if (!has_next) break;
#pragma unroll
        for (int a = 0; a < 2; ++a)
#pragma unroll
            for (int b = 0; b < 2; ++b)
#pragma unroll
                for (int m = 0; m < 4; ++m)
#pragma unroll
                    for (int n = 0; n < 2; ++n) acc[a][b][m][n] = (f32x4){0.f, 0.f, 0.f, 0.f};
        cur = nxt; cA = nA; cB = nB; ++ui;
        if constexpr (ALIGN_EPI) { if (wr == 1) PG8_BAR; }
    }
    PG8_WAIT_V(0);
    if constexpr (!ALIGN_EPI) { if (wr == 0) PG8_BAR; }
    PG8_BAR;
    if constexpr (Epi::AFTER_DRAIN) { E.fused(acc, cur, wr, wc, fr, fq, lds, wid, lane); S.done(cur); }
#undef PG8_SA
#undef PG8_SB
#undef PG8_STAGE
#undef PG8_LDA
#undef PG8_LDB
#undef PG8_MMA
#undef PG8_WAIT_V
#undef PG8_WAIT_L
#undef PG8_BAR
#undef PG8_SCHED
}
}
constexpr int D_MODEL = 1024, NBATCH = 2, SEQ = 16384, MROWS = NBATCH * SEQ, DFF = 4096, NMEM = 256, MEMROWS = NBATCH * NMEM;
constexpr int NTHREADS = 512, NWAVES = 8;
#define LAS __attribute__((address_space(3)))
#define GAS __attribute__((address_space(1)))
typedef pg8::bf16_t bf16_t;
typedef pg8::bf16x8 bf16x8;
typedef float f32x4 __attribute__((ext_vector_type(4)));
typedef float f32x16 __attribute__((ext_vector_type(16)));
typedef unsigned u32x4 __attribute__((ext_vector_type(4)));
typedef unsigned u32x2 __attribute__((ext_vector_type(2)));
typedef short s16x4 __attribute__((ext_vector_type(4)));
typedef float f32x2_t __attribute__((ext_vector_type(2)));
typedef __bf16 bf16x2_t __attribute__((ext_vector_type(2)));
#define LDS_WAIT() asm volatile("s_waitcnt lgkmcnt(0)" ::: "memory")

constexpr size_t MiB = 1u << 20;
constexpr size_t WS_CTL = 0, CTL_ZERO_BYTES = 65536;
constexpr size_t WS_SS = 1 * MiB;
constexpr size_t WS_C = 3 * MiB;
constexpr size_t WS_MEMB = 4 * MiB;
constexpr size_t WS_MEMKV = 480 * MiB;
constexpr int MEMKV_LD = 2112;
constexpr size_t WS_SSM = 7 * MiB;
constexpr size_t WS_TOT = 7 * MiB + 65536;
constexpr size_t WS_WINA = 8 * MiB;
constexpr size_t WS_WCAT = 15 * MiB;
constexpr size_t WS_WINB1 = 19 * MiB;
constexpr size_t WS_WMEM = 21 * MiB;
constexpr size_t WS_WO = 25 * MiB;
constexpr size_t WS_W1 = 31 * MiB;
constexpr size_t WS_W2 = 63 * MiB;
constexpr size_t WS_HB = 96 * MiB;
constexpr size_t WS_KSH = 160 * MiB, WS_VSH = 192 * MiB;
constexpr size_t WS_A = 224 * MiB;
constexpr size_t WS_MERGED = WS_A + 112 * MiB;
constexpr size_t WS_END = 484 * MiB;
constexpr int CW_KMAX = 16;
constexpr int CW_BAR = 4096;
constexpr int LDS_BYTES = 147456, MISC_OFF = 131072 + 320;

namespace att {
constexpr int KP = 144, VP = 192, KBUF = 64 * KP, VBUF = 64 * VP, CBUF = 256, BUFSZ = KBUF + VBUF + CBUF, FLAG_OFF = 2 * BUFSZ;
constexpr float LOG2E = 1.4426950408889634f;
__device__ __forceinline__ unsigned cvtpk(float lo, float hi) { f32x2_t v = {lo, hi}; bf16x2_t b = __builtin_convertvector(v, bf16x2_t); return __builtin_bit_cast(unsigned, b); }
__device__ __forceinline__ float bf2f(short s) { return __uint_as_float(((unsigned)(unsigned short)s) << 16); }
typedef short v4i16_t __attribute__((ext_vector_type(4)));
__device__ __forceinline__ s16x4 vtr(const LAS unsigned char* p) { return __builtin_bit_cast(s16x4, __builtin_amdgcn_ds_read_tr16_b64_v4i16((LAS v4i16_t*)p)); }

template <int MODE, bool MASKED>
__device__ __forceinline__ void attn_tile(const LAS unsigned char* B, const bf16x8 (&qf)[4], f32x16& o0, f32x16& o1, float& R, float& mrun, float& lrun, bool& wdone,
                                          int s0, int tw, int trow, int hi, unsigned kro, unsigned vro, float qkb, float ct2) {
    f32x16 p0 = {0}, p1 = {0};
#pragma unroll
    for (int c = 0; c < 4; ++c) {
        const bf16x8 a0 = *(const LAS bf16x8*)(B + kro + c * 32);
        const bf16x8 a1 = *(const LAS bf16x8*)(B + kro + 32 * KP + c * 32);
        p0 = __builtin_amdgcn_mfma_f32_32x32x16_bf16(a0, qf[c], p0, 0, 0, 0);
        p1 = __builtin_amdgcn_mfma_f32_32x32x16_bf16(a1, qf[c], p1, 0, 0, 0);
    }
    s16x4 vf0[8], vf1[8];
#pragma unroll
    for (int kd = 0; kd < 8; ++kd) { vf0[kd] = vtr(B + vro + (16 * (kd >> 1)) * VP + 64 * (kd & 1)); vf1[kd] = vtr(B + vro + (16 * (kd >> 1) + 4) * VP + 64 * (kd & 1)); }
    float x[32];
    constexpr bool masked = MASKED;
    const int kb0 = s0 + 8 * hi;
    if (MODE == 0) {
        float om[32];
#pragma unroll
        for (int e = 0; e < 32; ++e) {
            const float ex = __builtin_amdgcn_exp2f((e < 16 ? p0[e & 15] : p1[e & 15]) * LOG2E);
            om[e] = __builtin_amdgcn_rcpf(1.0f + ex); x[e] = 1.0f - om[e];
        }
        if (masked) {
#pragma unroll
            for (int e = 0; e < 32; ++e) if (kb0 + 16 * (e >> 3) + (e & 7) >= trow) { om[e] = 1.0f; x[e] = 0.f; }
        }
        float tot[4], pt[4], off[4];
#pragma unroll
        for (int k = 0; k < 4; ++k) tot[k] = ((om[8 * k] * om[8 * k + 1]) * (om[8 * k + 2] * om[8 * k + 3])) * ((om[8 * k + 4] * om[8 * k + 5]) * (om[8 * k + 6] * om[8 * k + 7]));
#pragma unroll
        for (int k = 0; k < 4; ++k) pt[k] = __shfl_xor(tot[k], 32);
        float suf = R;
#pragma unroll
        for (int k = 3; k >= 0; --k) { off[k] = hi ? suf : suf * pt[k]; suf *= tot[k] * pt[k]; }
        R = suf;
#pragma unroll
        for (int k = 0; k < 4; ++k) {
            float r = off[k];
#pragma unroll
            for (int j = 7; j >= 0; --j) { x[8 * k + j] *= r; r *= om[8 * k + j]; }
        }
        wdone = __all(R < 1e-12f) != 0;
    } else {
        if (MODE == 1) {
#pragma unroll
            for (int k = 0; k < 4; ++k) {
                const LAS f32x4* cp4 = (const LAS f32x4*)(B + KBUF + VBUF + (16 * k + 8 * hi) * 4);
                const f32x4 ca = cp4[0], cb = cp4[1];
#pragma unroll
                for (int j = 0; j < 8; ++j) { const int e = 8 * k + j; x[e] = (e < 16 ? p0[e & 15] : p1[e & 15]) * LOG2E + (ct2 - (j < 4 ? ca[j & 3] : cb[j & 3])); }
            }
            if (masked) {
#pragma unroll
                for (int e = 0; e < 32; ++e) if (kb0 + 16 * (e >> 3) + (e & 7) > trow) x[e] = -1e30f;
            }
        } else {
#pragma unroll
            for (int e = 0; e < 32; ++e) x[e] = (e < 16 ? p0[e & 15] : p1[e & 15]) * LOG2E;
        }
        float mx = x[0];
#pragma unroll
        for (int e = 1; e < 32; ++e) mx = fmaxf(mx, x[e]);
        mx = fmaxf(mx, __shfl_xor(mx, 32));
        const float mnew = fmaxf(mrun, mx), sc = __builtin_amdgcn_exp2f(mrun - mnew);
        mrun = mnew;
        float rs = 0.f;
#pragma unroll
        for (int e = 0; e < 32; ++e) { x[e] = __builtin_amdgcn_exp2f(x[e] - mnew); rs += x[e]; }
        rs += __shfl_xor(rs, 32);
        lrun = lrun * sc + rs;
#pragma unroll
        for (int r = 0; r < 16; ++r) { o0[r] *= sc; o1[r] *= sc; }
        if (MODE == 1) {
            const float c0 = *(const LAS float*)(B + KBUF + VBUF);
            wdone = __all((qkb + (ct2 - c0) - mrun) < -50.f) != 0;
        }
    }
#pragma unroll
    for (int k = 0; k < 4; ++k) {
        u32x4 pw; pw.x = cvtpk(x[8 * k], x[8 * k + 1]); pw.y = cvtpk(x[8 * k + 2], x[8 * k + 3]); pw.z = cvtpk(x[8 * k + 4], x[8 * k + 5]); pw.w = cvtpk(x[8 * k + 6], x[8 * k + 7]);
        const bf16x8 pf = __builtin_bit_cast(bf16x8, pw);
#pragma unroll
        for (int db = 0; db < 2; ++db) {
            const s16x4 lo = vf0[2 * k + db], h4 = vf1[2 * k + db];
            const bf16x8 vf = {lo[0], lo[1], lo[2], lo[3], h4[0], h4[1], h4[2], h4[3]};
            if (db == 0) o0 = __builtin_amdgcn_mfma_f32_32x32x16_bf16(vf, pf, o0, 0, 0, 0);
            else o1 = __builtin_amdgcn_mfma_f32_32x32x16_bf16(vf, pf, o1, 0, 0, 0);
        }
    }
}

#define ATT_GROUP_BAR() do { asm volatile("s_waitcnt lgkmcnt(0)" ::: "memory"); ++gen; \
        if (lane == 0) (void)__hip_atomic_fetch_add(gbar, 1u, __ATOMIC_RELAXED, __HIP_MEMORY_SCOPE_WORKGROUP); \
        while ((unsigned)__builtin_amdgcn_readfirstlane((int)*(volatile LAS unsigned*)gbar) < 4u * gen) __builtin_amdgcn_s_sleep(1); \
        asm volatile("" ::: "memory"); } while (0)
constexpr int GSZ = 45056;
template <int MODE>
__device__ __forceinline__ void attn_unit(LAS unsigned char* lds, LAS unsigned* gbar, unsigned& gen, const bf16_t* Qp, int ldq, const bf16_t* Kp, int ldk, const bf16_t* Vp, int ldv, bf16_t* Op, int ldo,
                                          const float* cq, const float* ck, float kmax2, int q0, int itile0) {
    int tid_l = threadIdx.x; asm volatile("" : "+v"(tid_l));
    const int tid = tid_l & 255, lane = tid & 63, wid = __builtin_amdgcn_readfirstlane(tid >> 6), r32 = lane & 31, hi = lane >> 5;
    const int tw = q0 + 32 * wid, trow = tw + r32;
    bf16x8 qf[4];
    { const bf16_t* qrow = Qp + (size_t)(32 * wid + r32) * ldq + 8 * hi;
#pragma unroll
      for (int c = 0; c < 4; ++c) qf[c] = *(const GAS bf16x8*)(qrow + 16 * c); }
    float qkb = 0.f, ct2 = 0.f;
    if (MODE == 1) {
        float s = 0.f;
#pragma unroll
        for (int c = 0; c < 4; ++c)
#pragma unroll
            for (int j = 0; j < 8; ++j) { const float v = bf2f(qf[c][j]); s += v * v; }
        s += __shfl_xor(s, 32);
        qkb = sqrtf(s) * kmax2 * 1.001f + 1e-3f;
        ct2 = *(const GAS float*)(cq + (size_t)(32 * wid + r32) * 8) * LOG2E;
    }
    const int srow = tid >> 3, sch = tid & 7;
    const bf16_t* kg = Kp + (size_t)srow * ldk + sch * 8; const bf16_t* vg = Vp + (size_t)srow * ldv + sch * 8;
    const unsigned kwo = srow * KP + sch * 16, vwo = KBUF + srow * VP + sch * 16;
    u32x4 kr0, kr1, vr0, vr1; float cr = 0.f;
#define ATT_LOAD(i) do { kr0 = *(const GAS u32x4*)(kg + (size_t)(i) * 64 * ldk); kr1 = *(const GAS u32x4*)(kg + (size_t)((i) * 64 + 32) * ldk); \
        vr0 = *(const GAS u32x4*)(vg + (size_t)(i) * 64 * ldv); vr1 = *(const GAS u32x4*)(vg + (size_t)((i) * 64 + 32) * ldv); \
        if (MODE == 1) cr = *(const GAS float*)(ck + (size_t)((i) * 64 + (tid & 63)) * 8) * LOG2E; } while (0)
#define ATT_STORE(b) do { *(LAS u32x4*)(lds + (b) * BUFSZ + kwo) = kr0; *(LAS u32x4*)(lds + (b) * BUFSZ + kwo + 32 * KP) = kr1; \
        *(LAS u32x4*)(lds + (b) * BUFSZ + vwo) = vr0; *(LAS u32x4*)(lds + (b) * BUFSZ + vwo + 32 * VP) = vr1; \
        if (MODE == 1 && tid < 64) *(LAS float*)(lds + (b) * BUFSZ + KBUF + VBUF + tid * 4) = cr; } while (0)
    f32x16 o0 = {0}, o1 = {0};
    float R = 1.f, mrun = -1e30f, lrun = 0.f;
    bool wdone = false;
    const int krow = (r32 & 0x13) | ((r32 & 4) << 1) | ((r32 & 8) >> 1);
    const unsigned kro = krow * KP + hi * 16;
    const unsigned vro = KBUF + (8 * hi + ((lane & 15) >> 2)) * VP + (16 * ((lane >> 4) & 1) + 4 * (lane & 3)) * 2;
    int i = itile0, cur = 0;
    ATT_LOAD(i); ATT_STORE(0);
    ATT_GROUP_BAR();
    for (;;) {
        ATT_LOAD((i > 0 ? i - 1 : 0));
        if (!wdone && (MODE == 2 || 64 * i <= tw)) {
            if (MODE != 2 && 64 * i + 64 > tw) attn_tile<MODE, true>(lds + cur * BUFSZ, qf, o0, o1, R, mrun, lrun, wdone, 64 * i, tw, trow, hi, kro, vro, qkb, ct2);
            else attn_tile<MODE, false>(lds + cur * BUFSZ, qf, o0, o1, R, mrun, lrun, wdone, 64 * i, tw, trow, hi, kro, vro, qkb, ct2);
        }
        if (i > 0) ATT_STORE(cur ^ 1);
        if (lane == 0) *(volatile LAS unsigned*)(lds + FLAG_OFF + (cur * 4 + wid) * 4) = wdone ? 0u : 1u;
        ATT_GROUP_BAR();
        if (i == 0) break;
        { const u32x4 fa = *(const LAS u32x4*)(lds + FLAG_OFF + cur * 16); if (((fa.x | fa.y) | (fa.z | fa.w)) == 0u) break; }
        --i; cur ^= 1;
    }
#undef ATT_LOAD
#undef ATT_STORE
    float inv = 1.f;
    if (MODE != 0) inv = 1.0f / lrun;
    bf16_t* orow = Op + (size_t)(32 * wid + r32) * ldo + 4 * hi;
#pragma unroll
    for (int g = 0; g < 4; ++g) {
        u32x2 w0; w0.x = cvtpk(o0[4 * g] * inv, o0[4 * g + 1] * inv); w0.y = cvtpk(o0[4 * g + 2] * inv, o0[4 * g + 3] * inv);
        u32x2 w1; w1.x = cvtpk(o1[4 * g] * inv, o1[4 * g + 1] * inv); w1.y = cvtpk(o1[4 * g + 2] * inv, o1[4 * g + 3] * inv);
        *(GAS u32x2*)(orow + 8 * g) = w0; *(GAS u32x2*)(orow + 32 + 8 * g) = w1;
    }
}
}

#define RLX_AGENT __ATOMIC_RELAXED, __HIP_MEMORY_SCOPE_AGENT
#define XB_TMO      128
#define XB_XCNT(j)  (256  + 64 * (j))
#define XB_XSUB(j)  (1280 + 64 * (j))
#define XB_XGEN(j)  (2304 + 64 * (j))
#define XB_TOP      3328
#define XB_TOPGEN   3392
#define XCD_BAR_WORDS 3456
#define XB_SPIN_CAP (1u << 18)

__device__ __forceinline__ unsigned xb_ld(unsigned* p)              { return __hip_atomic_load(p, __ATOMIC_RELAXED, __HIP_MEMORY_SCOPE_AGENT); }
__device__ __forceinline__ unsigned xb_add(unsigned* p, unsigned v) { return __hip_atomic_fetch_add(p, v, __ATOMIC_RELAXED, __HIP_MEMORY_SCOPE_AGENT); }
__device__ __forceinline__ unsigned xb_xcc_id() { return (unsigned)__builtin_amdgcn_s_getreg((3 << 11) | 20) & 0xFu; }
#define XB_SPIN(cond, bar) do { unsigned _sp = 0; while (cond) { __builtin_amdgcn_s_sleep(1); \
    if ((++_sp & 255u) == 0u) { if (xb_ld(&(bar)[XB_TMO])) break; if (_sp > XB_SPIN_CAP) { atomicAdd(&(bar)[XB_TMO], 1u); break; } } } } while (0)

struct XcdBarrier {
    unsigned* bar; unsigned x;
    volatile LAS unsigned* st;
};

__device__ __forceinline__ XcdBarrier xcd_barrier_post(unsigned* bar, volatile LAS unsigned* st) {
    XcdBarrier b; b.bar = bar; b.x = xb_xcc_id(); b.st = st;
    if (threadIdx.x == 0) (void)xb_add(&bar[XB_XCNT(b.x)], 1u);
    return b;
}
__device__ __forceinline__ void xcd_barrier_complete(unsigned* bar, unsigned x, unsigned& nloc, unsigned& nx) {
    const unsigned G = gridDim.x * gridDim.y * gridDim.z;
    unsigned sum, cnt, mine, sp = 0u;
    for (;;) {
        sum = 0u; cnt = 0u; mine = 0u;
#pragma unroll
        for (unsigned j = 0; j < 16; ++j) { const unsigned c = xb_ld(&bar[XB_XCNT(j)]); sum += c; cnt += (c > 0u) ? 1u : 0u; mine = (j == x) ? c : mine; }
        if (sum == G) break;
        __builtin_amdgcn_s_sleep(1);
        if ((++sp & 255u) == 0u) { if (xb_ld(&bar[XB_TMO])) break; if (sp > XB_SPIN_CAP) { atomicAdd(&bar[XB_TMO], 1u); break; } }
    }
    nloc = mine > 0u ? mine : 1u; nx = cnt > 0u ? cnt : 1u;
}

__device__ __forceinline__ void xcd_barrier(const XcdBarrier& b) {
    asm volatile("s_waitcnt vmcnt(0)" ::: "memory");
    __syncthreads();
    if (threadIdx.x == 0) {
        unsigned* bar = b.bar;
        __builtin_amdgcn_s_waitcnt(0);
        unsigned nloc = b.st[0], nx = b.st[1];
        if (nloc == 0u) { xcd_barrier_complete(bar, b.x, nloc, nx); b.st[0] = nloc; b.st[1] = nx; }
        const unsigned old = xb_add(&bar[XB_XSUB(b.x)], 1u);
        const unsigned gen = old / nloc;
        if (old + 1u == (gen + 1u) * nloc) {
            __builtin_amdgcn_fence(__ATOMIC_RELEASE, "agent");
            asm volatile("s_waitcnt vmcnt(0)" ::: "memory");
            const unsigned og = xb_add(&bar[XB_TOP], 1u);
            const unsigned tg = og / nx;
            if (og + 1u == (tg + 1u) * nx) xb_add(&bar[XB_TOPGEN], 1u);
            else XB_SPIN(xb_ld(&bar[XB_TOPGEN]) == tg, bar);
            __builtin_amdgcn_fence(__ATOMIC_ACQUIRE, "agent");
            xb_add(&bar[XB_XGEN(b.x)], 1u);
            asm volatile("s_waitcnt vmcnt(0)" ::: "memory");
        } else {
            XB_SPIN(xb_ld(&bar[XB_XGEN(b.x)]) == gen, bar);
            __builtin_amdgcn_fence(__ATOMIC_ACQUIRE, "agent");
            asm volatile("s_waitcnt vmcnt(0)" ::: "memory");
        }
    }
    __syncthreads();
}

__device__ __forceinline__ float wave_sum(float v) {
#pragma unroll
    for (int o = 1; o < 64; o <<= 1) v += __shfl_xor(v, o);
    return v;
}
__device__ __forceinline__ unsigned f2bf(float f) { unsigned u = __builtin_bit_cast(unsigned, f); return (u + 0x7fffu + ((u >> 16) & 1u)) >> 16; }
__device__ __forceinline__ unsigned pk2(float lo, float hi) { return f2bf(lo) | (f2bf(hi) << 16); }
__device__ __forceinline__ void conv_item(const float* W, int K, int N, const float* g, bf16_t* WT, int s_lo, int s_hi, LAS float* scr, int item, int lane) {
    const int nblk = (N + 31) / 32, kb = item / nblk, nb = item - kb * nblk, k0 = 64 * kb, n0 = 32 * nb;
    const int nl = n0 + (lane & 31);
    float v[32];
    const float* wp = W + (size_t)(k0 + (lane >> 5)) * N + nl;
#pragma unroll
    for (int i = 0; i < 32; ++i) v[i] = (nl < N) ? *(const GAS float*)(wp + (size_t)(2 * i) * N) : 0.f;
    const int c = lane & 7;
    f32x4 g0 = {1.f, 1.f, 1.f, 1.f}, g1 = {1.f, 1.f, 1.f, 1.f};
    if (g) { g0 = *(const GAS f32x4*)(g + k0 + 8 * c); g1 = *(const GAS f32x4*)(g + k0 + 8 * c + 4); }
#pragma unroll
    for (int i = 0; i < 32; ++i) scr[(2 * i + (lane >> 5)) * 33 + (lane & 31)] = v[i];
    LDS_WAIT(); asm volatile("" ::: "memory");
#pragma unroll
    for (int j = 0; j < 4; ++j) {
        const int n = (lane >> 3) + 8 * j; const LAS float* s = scr + (8 * c) * 33 + n;
        const float cs = ((n0 + n) < s_lo || (n0 + n) >= s_hi) ? 0.125f : 1.0f;
        u32x4 o; o.x = pk2(s[0 * 33] * g0[0] * cs, s[1 * 33] * g0[1] * cs); o.y = pk2(s[2 * 33] * g0[2] * cs, s[3 * 33] * g0[3] * cs);
        o.z = pk2(s[4 * 33] * g1[0] * cs, s[5 * 33] * g1[1] * cs); o.w = pk2(s[6 * 33] * g1[2] * cs, s[7 * 33] * g1[3] * cs);
        if (n0 + n < N) *(GAS u32x4*)(WT + (size_t)(n0 + n) * K + k0 + 8 * c) = o;
    }
    LDS_WAIT(); asm volatile("" ::: "memory");
}
__device__ __forceinline__ void rows2_to_bf16(const float* xrow, bf16_t* orow, float* ssrow, int lane) {
    const GAS f32x4* xr = (const GAS f32x4*)xrow + lane;
    f32x4 v[8]; float s0 = 0.f, s1 = 0.f;
#pragma unroll
    for (int j = 0; j < 8; ++j) v[j] = xr[64 * j];
#pragma unroll
    for (int j = 0; j < 4; ++j) { s0 += (v[j][0] * v[j][0] + v[j][1] * v[j][1]) + (v[j][2] * v[j][2] + v[j][3] * v[j][3]);
                                  s1 += (v[4 + j][0] * v[4 + j][0] + v[4 + j][1] * v[4 + j][1]) + (v[4 + j][2] * v[4 + j][2] + v[4 + j][3] * v[4 + j][3]); }
    GAS u32x2* o8 = (GAS u32x2*)orow + lane;
#pragma unroll
    for (int j = 0; j < 8; ++j) { u32x2 w; w.x = pk2(v[j][0], v[j][1]); w.y = pk2(v[j][2], v[j][3]); o8[64 * j] = w; }
    s0 = wave_sum(s0); s1 = wave_sum(s1);
    if (lane < 8) ssrow[lane] = (lane == 0) ? s0 : (lane == 4 ? s1 : 0.f);
}

struct Params { const float* in[15]; float* out; unsigned char* ws; };

__global__ void __launch_bounds__(NTHREADS, 2) yoco_fwd(Params P) {
    extern __shared__ __attribute__((aligned(16))) unsigned char lds_raw[];
    cg::grid_group grid = cg::this_grid();
    LAS unsigned char* lds = (LAS unsigned char*)lds_raw;
    const int G = gridDim.x, bx = blockIdx.x;
    for (int u = threadIdx.x; u < (LDS_BYTES - 131072) / 4; u += NTHREADS) ((LAS unsigned*)(lds + 131072))[u] = 0u;
    __syncthreads();
    const XcdBarrier xbar = xcd_barrier_post((unsigned*)(P.ws + WS_CTL) + CW_BAR, (volatile LAS unsigned*)(lds + MISC_OFF));
#define WSP(T, off) ((T*)(ws + (off)))
#define g_ctl WSP(unsigned, WS_CTL)
#define g_ss WSP(float, WS_SS)
#define g_cbuf WSP(float, WS_C)
#define g_ssm WSP(float, WS_SSM)
#define g_totb WSP(float, WS_TOT)
#define g_memb WSP(bf16_t, WS_MEMB)
#define g_memkv WSP(bf16_t, WS_MEMKV)
#define g_Wina WSP(bf16_t, WS_WINA)
#define g_Wcat WSP(bf16_t, WS_WCAT)
#define g_Winb1 WSP(bf16_t, WS_WINB1)
#define g_Wmem WSP(bf16_t, WS_WMEM)
#define g_Wo WSP(bf16_t, WS_WO)
#define g_W1 WSP(bf16_t, WS_W1)
#define g_W2 WSP(bf16_t, WS_W2)
#define g_hb WSP(bf16_t, WS_HB)
#define g_Ksh WSP(bf16_t, WS_KSH)
#define g_Vsh WSP(bf16_t, WS_VSH)
#define g_proj WSP(bf16_t, WS_A)
#define g_merged WSP(bf16_t, WS_MERGED)
#define g_hidden WSP(bf16_t, WS_A)
#define g_hout (P.out)

    {
        unsigned char* ws = P.ws;
        const int tid = threadIdx.x, lane = tid & 63, wave = __builtin_amdgcn_readfirstlane(tid >> 6);
        LAS float* scr = (LAS float*)(lds + wave * 16384);
        const int gw = bx * NWAVES + wave, NGW = G * NWAVES;
        for (int mi = 0; mi < 21; ++mi) {
            const float* W; const float* g = nullptr; bf16_t* WT; int K = 1024, N, s_lo = 0, s_hi = 0x7fffffff;
            if (mi < 2) { W = P.in[3] + (size_t)mi * 1024 * 1792; N = 1792; g = P.in[2] + mi * 1024; WT = g_Wina + (size_t)mi * 1792 * 1024; s_lo = 512; s_hi = 1536; }
            else if (mi == 2) { W = P.in[4]; N = 768; g = P.in[2] + 2 * 1024; WT = g_Wcat; s_lo = 768; }
            else if (mi == 3) { W = P.in[12]; N = 1032; g = P.in[11]; WT = g_Wcat + (size_t)768 * 1024; }
            else if (mi == 4) { W = P.in[4] + (size_t)1024 * 768; N = 768; g = P.in[2] + 3 * 1024; WT = g_Winb1; s_lo = 768; }
            else if (mi < 9) { const int l = mi - 5; W = P.in[5] + (size_t)l * 1024 * 512; N = 512; g = P.in[6] + l * 1024; WT = g_Wmem + (size_t)l * 512 * 1024; }
            else if (mi < 13) { const int l = mi - 9; W = P.in[7] + (size_t)l * 768 * 1024; K = 768; N = 1024; WT = g_Wo + (size_t)l * 1024 * 768; }
            else if (mi < 17) { const int l = mi - 13; W = P.in[9] + (size_t)l * 1024 * 4096; N = 4096; g = P.in[8] + l * 1024; WT = g_W1 + (size_t)l * 4096 * 1024; }
            else { const int l = mi - 17; W = P.in[10] + (size_t)l * 4096 * 1024; K = 4096; N = 1024; WT = g_W2 + (size_t)l * 1024 * 4096; }
            const int nitems = (K / 64) * ((N + 31) / 32);
            for (int it = gw; it < nitems; it += NGW) conv_item(W, K, N, g, WT, s_lo, s_hi, scr, it, lane);
        }
        { u32x4* z = (u32x4*)(g_Wcat + (size_t)1800 * 1024); const int nz = 248 * 1024 * 2 / 16; const u32x4 zero = {0u, 0u, 0u, 0u};
          for (int e = gw * 64 + lane; e < nz; e += NGW * 64) z[e] = zero; }
        for (int m = 2 * gw; m < MROWS; m += 2 * NGW) rows2_to_bf16(P.in[0] + (size_t)m * 1024, g_hb + (size_t)m * 1024, g_ss + (size_t)m * 4, lane);
        for (int m = 2 * gw; m < MEMROWS; m += 2 * NGW) rows2_to_bf16(P.in[1] + (size_t)m * 1024, g_memb + (size_t)m * 1024, g_ssm + (size_t)m * 4, lane);
    }
    grid.sync();

    for (int l = 0; l < 4; ++l) {
        for (int sub = 0; sub < 5; ++sub) {
            unsigned char* ws = P.ws; asm volatile("" : "+s"(ws));
            int tid = threadIdx.x; asm volatile("" : "+v"(tid)); const int lane = tid & 63;
            switch (sub) {
            case 0: case 3: {
                for (int pass = (l == 0 && sub == 0) ? 0 : 1; pass < 2; ++pass) {
                    pg8::Gemm g; pg8::EpiProj E; E.ss = g_ss; E.act = 0; E.cat = 0; E.Ksh = g_Ksh; E.Vsh = g_Vsh; E.flog = g_cbuf; int cidx = bx;
                    if (pass == 0) { g.A = g_memb; g.Bt = g_Wmem; g.M = MEMROWS; g.N = 2048; g.K = 1024; E.ss = g_ssm; E.O = g_memkv; E.ldc = MEMKV_LD; cidx = (bx + G / 2) % G; }
                    else if (sub == 3) { g.A = g_hb; g.Bt = g_W1 + (size_t)l * 4096 * 1024; g.M = MROWS; g.N = DFF; g.K = 1024; E.O = g_hidden; E.ldc = DFF; E.act = 1; }
                    else if (l < 2) { g.A = g_hb; g.Bt = g_Wina + (size_t)l * 1792 * 1024; g.M = MROWS; g.N = 1792; g.K = 1024; E.O = g_proj; E.ldc = 1792; }
                    else if (l == 2) { g.A = g_hb; g.Bt = g_Wcat; g.M = MROWS; g.N = 2048; g.K = 1024; E.O = g_proj; E.ldc = 768; E.cat = 1; }
                    else { g.A = g_hb; g.Bt = g_Winb1; g.M = MROWS; g.N = 768; g.K = 1024; E.O = g_proj; E.ldc = 768; }
                    pg8::StaticOrder S; S.init(g.M, g.N, G, cidx);
                    pg8::gemm_phase<pg8::EpiProj, pg8::StaticOrder, true, true>(lds, g, S, E);
                }
            } break;
            case 1: {
                if (l == 2) {
                    LAS float* sb = (LAS float*)lds;
                    for (int ch = bx; ch < MROWS / 128; ch += G) {
                        const int r0 = ch * 128;
                        for (int e = tid; e < 1024; e += NTHREADS) {
                            const float f = g_cbuf[(size_t)r0 * 8 + e] + P.in[13][e & 7];
                            sb[e] = -(fmaxf(-f, 0.f) + log1pf(expf(-fabsf(f))));
                        }
                        __syncthreads();
                        if (tid < 8) { float a = 0.f; for (int r = 0; r < 128; ++r) { a += sb[r * 8 + tid]; sb[r * 8 + tid] = a; } g_totb[ch * 8 + tid] = a; }
                        __syncthreads();
                        for (int e = tid; e < 1024; e += NTHREADS) g_cbuf[(size_t)r0 * 8 + e] = sb[e];
                        float mx = 0.f;
                        for (int e = tid; e < 1024; e += NTHREADS) {
                            const bf16x8* kp = (const bf16x8*)(g_Ksh + (size_t)(r0 + (e >> 3)) * 512 + (e & 7) * 64); float s = 0.f;
#pragma unroll
                            for (int c = 0; c < 8; ++c) { const bf16x8 v = kp[c];
#pragma unroll
                                for (int j = 0; j < 8; ++j) { const float f = att::bf2f(v[j]); s += f * f; } }
                            mx = fmaxf(mx, s);
                        }
                        mx = fmaxf(mx, __shfl_xor(mx, 8)); mx = fmaxf(mx, __shfl_xor(mx, 16)); mx = fmaxf(mx, __shfl_xor(mx, 32));
                        if (lane < 8) atomicMax(g_ctl + CW_KMAX + (r0 >> 14) * 8 + lane, __float_as_uint(mx));
                        __syncthreads();
                    }
                    xcd_barrier(xbar);
                    for (int ch = bx; ch < MROWS / 128; ch += G) {
                        const int r0 = ch * 128, c0 = ch & ~127;
                        {
                          const int hd8 = tid & 7, j = tid >> 3; float a = 0.f;
                          if (c0 + j < ch) a += *(const GAS float*)(g_totb + (size_t)(c0 + j) * 8 + hd8);
                          if (c0 + 64 + j < ch) a += *(const GAS float*)(g_totb + (size_t)(c0 + 64 + j) * 8 + hd8);
                          a += __shfl_xor(a, 8); a += __shfl_xor(a, 16); a += __shfl_xor(a, 32);
                          if (lane < 8) sb[16 + (tid >> 6) * 8 + lane] = a;
                          __syncthreads();
                          if (tid < 8) { float s = 0.f;
#pragma unroll
                              for (int w = 0; w < 8; ++w) s += sb[16 + w * 8 + tid];
                              sb[tid] = s; }
                        }
                        __syncthreads();
                        for (int e = tid; e < 1024; e += NTHREADS) g_cbuf[(size_t)r0 * 8 + e] += sb[e & 7];
                        __syncthreads();
                    }
                    xcd_barrier(xbar);
                }
                {
                    const int ldp = (l < 2) ? 1792 : 768;
                    const int grp = __builtin_amdgcn_readfirstlane(tid >> 8);
                    LAS unsigned char* glds = lds + grp * att::GSZ;
                    LAS unsigned* gbar = (LAS unsigned*)(lds + 131072 + 16) + grp;
                    __syncthreads();
                    unsigned gen = (unsigned)__builtin_amdgcn_readfirstlane((int)*(volatile LAS unsigned*)gbar) >> 2;
                    for (int u = 2 * bx + grp; u < 3072; u += 2 * G) {
                        if (u < 2048) {
                            const int gq = u & 511, kk = u >> 9, cb = gq >> 1, bh = (cb & 7) * 2 + (cb >> 7), qb = (((cb >> 3) & 15) * 2 + (gq & 1)) * 4 + kk, hd = bh & 7, b = bh >> 3, q0 = 128 * qb;
                            const size_t rq = (size_t)b * SEQ + q0, rk = (size_t)b * SEQ;
                            if (l < 2) att::attn_unit<0>(glds, gbar, gen, g_proj + rq * 1792 + hd * 64, 1792, g_proj + rk * 1792 + 512 + hd * 64, 1792, g_proj + rk * 1792 + 1024 + hd * 64, 1792,
                                                         g_merged + rq * 768 + hd * 64, 768, nullptr, nullptr, 0.f, q0, (q0 >> 6) + 1);
                            else { const float kmax2 = sqrtf(__uint_as_float(g_ctl[CW_KMAX + b * 8 + hd])) * att::LOG2E;
                                   att::attn_unit<1>(glds, gbar, gen, g_proj + rq * 768 + hd * 64, 768, g_Ksh + rk * 512 + hd * 64, 512, g_Vsh + rk * 512 + hd * 64, 512,
                                                     g_merged + rq * 768 + hd * 64, 768, g_cbuf + rq * 8 + hd, g_cbuf + rk * 8 + hd, kmax2, q0, (q0 >> 6) + 1); }
                        } else {
                            const int u2 = u - 2048, rb = u2 & 255, hm = u2 >> 8; const size_t rq = (size_t)rb * 128; const int b = (int)(rq >> 14);
                            const bf16_t* qp = g_proj + rq * ldp + ((l < 2) ? 1536 : 512) + hm * 64;
                            const bf16_t* kp = g_memkv + (size_t)(b * NMEM) * MEMKV_LD + l * 512 + hm * 64;
                            att::attn_unit<2>(glds, gbar, gen, qp, ldp, kp, MEMKV_LD, kp + 256, MEMKV_LD, g_merged + rq * 768 + 512 + hm * 64, 768, nullptr, nullptr, 0.f, 0, 3);
                        }
                    }
                    __syncthreads();
                }
            } break;
            default: {
                pg8::Gemm g; g.M = MROWS; g.N = 1024;
                if (sub == 2) { g.A = g_merged; g.Bt = g_Wo + (size_t)l * 1024 * 768; g.K = 768; } else { g.A = g_hidden; g.Bt = g_W2 + (size_t)l * 1024 * 4096; g.K = DFF; }
                pg8::EpiRes E; E.hb = g_hb; E.ss = g_ss; E.red = (LAS float*)(lds + 131072 + 1024);
                pg8::StaticOrder S; S.init(g.M, g.N, G, bx);
                pg8::gemm_phase<pg8::EpiRes, pg8::StaticOrder, true, true>(lds, g, S, E);
            } break;
            }
            xcd_barrier(xbar);
        }
    }
    {
        unsigned char* ws = P.ws; asm volatile("" : "+s"(ws));
        int tid_l = threadIdx.x; asm volatile("" : "+v"(tid_l));
        const int tid = tid_l, lane = tid & 63, wave = __builtin_amdgcn_readfirstlane(tid >> 6);
        const int gw = bx * NWAVES + wave, NGW = G * NWAVES;
        const f32x4* gp = (const f32x4*)P.in[14] + lane;
        f32x4 gv[4];
#pragma unroll
        for (int j = 0; j < 4; ++j) gv[j] = gp[64 * j];
        for (int m = gw; m < MROWS; m += NGW) {
            float s = (lane < 4) ? *(const GAS float*)(g_ss + (size_t)m * 4 + lane) : 0.f;
            s = wave_sum(s);
            const float rs = 1.0f / sqrtf(s * (1.0f / 1024.0f) + pg8::RMS_EPS);
            const GAS u32x2* hr = (const GAS u32x2*)(g_hb + (size_t)m * 1024) + lane;
            GAS f32x4* xr = (GAS f32x4*)(g_hout + (size_t)m * 1024) + lane;
#pragma unroll
            for (int j = 0; j < 4; ++j) { const u32x2 w = hr[64 * j]; const f32x4 v = {pg8::bf_lo(w.x), pg8::bf_hi(w.x), pg8::bf_lo(w.y), pg8::bf_hi(w.y)}; xr[64 * j] = v * rs * gv[j]; }
        }
    }
}

extern "C" void kernel_launch(void* const* d_in, const int* in_sizes, int n_in, void* d_out, int out_size, void* d_ws, size_t ws_size, hipStream_t stream) {
    static int grid = 0;
    if (grid == 0) {
        if (n_in != 15 || in_sizes[0] != MROWS * D_MODEL || out_size != MROWS * D_MODEL || ws_size < WS_END) {
            fprintf(stderr, "kernel_launch: unexpected shapes / workspace (n_in %d, in0 %d, out %d, ws %zu < %zu); nothing launched\n", n_in, n_in > 0 ? in_sizes[0] : -1, out_size, ws_size, (size_t)WS_END);
            grid = -1; return;
        }
        int dev = 0, cus = 0, per_cu = 0;
        if (hipGetDevice(&dev) != hipSuccess || hipDeviceGetAttribute(&cus, hipDeviceAttributeMultiprocessorCount, dev) != hipSuccess) { fprintf(stderr, "kernel_launch: device query failed\n"); grid = -1; return; }
        if (hipFuncSetAttribute((const void*)yoco_fwd, hipFuncAttributeMaxDynamicSharedMemorySize, LDS_BYTES) != hipSuccess) { fprintf(stderr, "kernel_launch: hipFuncSetAttribute failed\n"); grid = -1; return; }
        if (hipOccupancyMaxActiveBlocksPerMultiprocessor(&per_cu, (const void*)yoco_fwd, NTHREADS, LDS_BYTES) != hipSuccess || per_cu < 1) { fprintf(stderr, "kernel_launch: occupancy query says %d\n", per_cu); per_cu = 1; }
        (void)hipGetLastError();
        grid = cus * 1;
    }
    if (grid < 0) return;
    (void)hipMemsetAsync((char*)d_ws + WS_CTL, 0, CTL_ZERO_BYTES, stream);
    Params p{};
    for (int i = 0; i < 15; ++i) p.in[i] = (const float*)d_in[i];
    p.out = (float*)d_out; p.ws = (unsigned char*)d_ws;
    void* args[] = {&p};
    hipError_t e = hipLaunchCooperativeKernel((const void*)yoco_fwd, dim3(grid), dim3(NTHREADS), args, LDS_BYTES, stream);
    if (e != hipSuccess) fprintf(stderr, "kernel_launch: cooperative launch failed: %s (grid %d)\n", hipGetErrorString(e), grid);
}
```

```cpp
#include <hip/hip_runtime.h>
#include <hip/hip_cooperative_groups.h>
#include <cstdio>
#include <cstdint>
namespace cg = cooperative_groups;
namespace pg8 {
#define PG8_LAS __attribute__((address_space(3)))
typedef unsigned short bf16_t;
typedef short bf16x8 __attribute__((ext_vector_type(8)));
typedef float f32x4 __attribute__((ext_vector_type(4)));
typedef unsigned u32x4 __attribute__((ext_vector_type(4)));
constexpr int BM = 256, BK = 64, HALF = 128, HTB = HALF * BK * 2  , STAGE_BYTES = 8 * HTB, NXCD = 8, WGM = 8;

__host__ __device__ __forceinline__ int lds_byte(int r, int c) { const int st = (r >> 4) * 2 + (c >> 5), rr = r & 15, cc = c & 31, ob = rr * 64 + cc * 2; return st * 1024 + (ob ^ (((ob >> 9) & 1) << 5)); }
__host__ __device__ __forceinline__ void stage_rc(int b, int& R, int& C) { const int st = b / 1024, sb = b % 1024, swz = sb ^ (((sb >> 9) & 1) << 5); R = (st >> 1) * 16 + swz / 64; C = (st & 1) * 32 + (swz % 64) / 2; }
__host__ __device__ __forceinline__ int perm32(int rho) { const int n = rho >> 4, i = rho & 15; return 8 * (i >> 2) + 4 * n + (i & 3); }

struct Unit { int pm, pn; };
struct Gemm { const bf16_t* A; const bf16_t* Bt; int M, N, K; };

struct StaticOrder {
    int nM, nN, nwg, G, c;
    __host__ __device__ void init(int M, int N, int G_, int c_) { nM = M / BM; nN = N / BM; nwg = nM * nN; G = G_; c = c_; }
    __host__ __device__ bool next(int i, Unit& u) const {
        const long L = (long)i * G + c; if (L >= nwg) return false;
        int wgid = (int)L; { const int q = nwg / NXCD, r = nwg % NXCD, xcd = wgid % NXCD, off = wgid / NXCD; wgid = (xcd < r ? xcd * (q + 1) : r * (q + 1) + (xcd - r) * q) + off; }
        const int nig = WGM * nN, gid = wgid / nig, fm = gid * WGM, gsz = (nM - fm) < WGM ? (nM - fm) : WGM;
        u.pm = fm + ((wgid % nig) % gsz); u.pn = (wgid % nig) / gsz; return true;
    }
    __device__ __forceinline__ void a_ready(const Unit&) const {}
    __device__ __forceinline__ void done(const Unit&) const {}
};
__device__ __forceinline__ unsigned cvt_pk_bf16(float lo, float hi) { unsigned r; asm volatile("v_cvt_pk_bf16_f32 %0, %1, %2" : "=v"(r) : "v"(lo), "v"(hi)); return r; }
constexpr float RMS_EPS = 1e-6f;
typedef unsigned u32x2 __attribute__((ext_vector_type(2)));
#define PG8_GAS __attribute__((address_space(1)))
struct EpiProj {
    static constexpr bool PERM = true, AFTER_DRAIN = false;
    const float* ss; bf16_t* O; int ldc; int act; int cat; bf16_t* Ksh; bf16_t* Vsh; float* flog;
    __device__ __forceinline__ void operator()(const f32x4 (&acc)[2][2][4][2], const Unit& u, int wr, int wc, int fr, int fq) const {
        const int row0 = u.pm * BM + wr * 64 + fr;
        bf16_t* base = O; int ld = ldc; int colt = u.pn * BM; int kind = 0;
        if (cat) { if (u.pn >= 7) kind = 2; else if (u.pn >= 5) { base = Vsh; ld = 512; colt = (u.pn - 5) * BM; } else if (u.pn >= 3) { base = Ksh; ld = 512; colt = (u.pn - 3) * BM; } }
        const int col0 = colt + wc * 32 + 8 * fq;
        f32x4 sv[2][4];
#pragma unroll
        for (int ai = 0; ai < 2; ++ai)
#pragma unroll
            for (int m = 0; m < 4; ++m) sv[ai][m] = *(const PG8_GAS f32x4*)(ss + (size_t)(row0 + ai * HALF + m * 16) * 4);
#pragma unroll
        for (int ai = 0; ai < 2; ++ai)
#pragma unroll
            for (int m = 0; m < 4; ++m) {
                const int row = row0 + ai * HALF + m * 16;
                const f32x4 sa = sv[ai][m];
                const float t = (sa[0] + sa[1]) + (sa[2] + sa[3]);
                const float rs = __builtin_amdgcn_rsqf(t * (1.0f / 1024.0f) + RMS_EPS);
                if (kind == 2) {
                    if (wc == 0 && fq == 0) { const f32x4 v0 = acc[ai][0][m][0] * rs, v1 = acc[ai][0][m][1] * rs; *(PG8_GAS f32x4*)(flog + (size_t)row * 8) = v0; *(PG8_GAS f32x4*)(flog + (size_t)row * 8 + 4) = v1; }
                } else {
                    bf16_t* rowp = base + (size_t)row * ld + col0;
#pragma unroll
                    for (int bj = 0; bj < 2; ++bj) {
                        f32x4 v0 = acc[ai][bj][m][0] * rs, v1 = acc[ai][bj][m][1] * rs;
                        if (act) {
#pragma unroll
                            for (int j = 0; j < 4; ++j) { const float a = fmaxf(v0[j], 0.f), b = fmaxf(v1[j], 0.f); v0[j] = a * a; v1[j] = b * b; }
                        }
                        u32x4 w; w.x = cvt_pk_bf16(v0[0], v0[1]); w.y = cvt_pk_bf16(v0[2], v0[3]); w.z = cvt_pk_bf16(v1[0], v1[1]); w.w = cvt_pk_bf16(v1[2], v1[3]);
                        *(PG8_GAS u32x4*)(rowp + bj * HALF) = w;
                    }
                }
            }
    }
};
__device__ __forceinline__ float bf_lo(unsigned w) { return __uint_as_float(w << 16); }
__device__ __forceinline__ float bf_hi(unsigned w) { return __uint_as_float(w & 0xffff0000u); }
struct EpiRes {
    static constexpr bool PERM = false, AFTER_DRAIN = false;
    bf16_t* hb; float* ss; PG8_LAS float* red;
    __device__ __forceinline__ void operator()(const f32x4 (&acc)[2][2][4][2], const Unit& u, int wr, int wc, int fr, int fq) const {
        const int col0 = u.pn * BM + wc * 32 + 4 * fq;
#pragma unroll
        for (int ai = 0; ai < 2; ++ai) {
            u32x2 b[4][2][2];
#pragma unroll
            for (int m = 0; m < 4; ++m) {
                const size_t off = (size_t)(u.pm * BM + ai * HALF + wr * 64 + m * 16 + fr) * 1024 + col0;
#pragma unroll
                for (int bj = 0; bj < 2; ++bj)
#pragma unroll
                    for (int n = 0; n < 2; ++n) b[m][bj][n] = *(const PG8_GAS u32x2*)(hb + off + bj * HALF + n * 16);
            }
#pragma unroll
            for (int m = 0; m < 4; ++m) {
                const int rt = ai * HALF + wr * 64 + m * 16 + fr; const size_t off = (size_t)(u.pm * BM + rt) * 1024 + col0; float q = 0.f;
#pragma unroll
                for (int bj = 0; bj < 2; ++bj)
#pragma unroll
                    for (int n = 0; n < 2; ++n) {
                        const f32x4 a = acc[ai][bj][m][n]; const u32x2 bb = b[m][bj][n];
                        u32x2 w; w.x = cvt_pk_bf16(bf_lo(bb.x) + a[0], bf_hi(bb.x) + a[1]); w.y = cvt_pk_bf16(bf_lo(bb.y) + a[2], bf_hi(bb.y) + a[3]);
                        *(PG8_GAS u32x2*)(hb + off + bj * HALF + n * 16) = w;
                        const float o0 = bf_lo(w.x), o1 = bf_hi(w.x), o2 = bf_lo(w.y), o3 = bf_hi(w.y);
                        q += (o0 * o0 + o1 * o1) + (o2 * o2 + o3 * o3);
                    }
                q += __shfl_xor(q, 16); q += __shfl_xor(q, 32);
                if (fq == 0) red[rt * 4 + wc] = q;
            }
            asm volatile("" ::: "memory");
        }
        asm volatile("s_waitcnt lgkmcnt(0)" ::: "memory"); __builtin_amdgcn_s_barrier(); asm volatile("" ::: "memory");
        int t = threadIdx.x; asm volatile("" : "+v"(t));
        if (t < 256) { const f32x4 v = *(const PG8_LAS f32x4*)(red + t * 4); *(PG8_GAS float*)(ss + (size_t)(u.pm * BM + t) * 4 + u.pn) = (v[0] + v[1]) + (v[2] + v[3]); }
    }
};
template <class Epi, class Sched, bool ALIGN_EPI = false, bool SP2 = false>
__device__ __forceinline__ void gemm_phase(PG8_LAS unsigned char* lds, const Gemm g, const Sched& S, const Epi& E) {
    int tid_l = threadIdx.x; asm volatile("" : "+v"(tid_l));
    const int tid = tid_l, wid = __builtin_amdgcn_readfirstlane(tid >> 6), lane = tid & 63, wr = wid >> 2, wc = wid & 3, fr = lane & 15, fq = lane >> 4;
    const int K = g.K, nt = K / BK;
    unsigned voffA[2], voffB[2];
#pragma unroll
    for (int i = 0; i < 2; ++i) { int R, C; stage_rc(tid * 16 + i * 8192, R, C); const int Rb = Epi::PERM ? ((R & ~31) + perm32(R & 31)) : R;
        voffA[i] = (unsigned)(R * K + C) * 2u; voffB[i] = (unsigned)(Rb * K + C) * 2u; }
    const size_t kstep = (size_t)(BK * 2);
    const size_t hstep = (size_t)HALF * K * 2;
    const size_t tstep = 2 * hstep;
    const unsigned ldsw = (unsigned)wid * 1024u;
    const int aoff = lds_byte(wr * 64 + fr, fq * 8), boff = lds_byte(wc * 32 + fr, fq * 8);
#define PG8_SA(b, h) (((b) * 2 + (h)) * HTB)
#define PG8_SB(b, h) ((4 + (b) * 2 + (h)) * HTB)
#define PG8_STAGE(bufoff, gbase, voff) do { _Pragma("unroll") for (int _i = 0; _i < 2; ++_i) \
        __builtin_amdgcn_global_load_lds((const unsigned*)((const char*)(gbase) + (voff)[_i]), (PG8_LAS unsigned*)(lds + (bufoff) + ldsw + _i * 8192), 16, 0, 0); } while (0)
#define PG8_LDA(dst, b, h) do { _Pragma("unroll") for (int m = 0; m < 4; ++m) _Pragma("unroll") for (int k = 0; k < 2; ++k) dst[m][k] = *(const PG8_LAS bf16x8*)(lds + PG8_SA(b, h) + aoff + m * 2048 + k * 1024); } while (0)
#define PG8_LDB(dst, b, h) do { _Pragma("unroll") for (int n = 0; n < 2; ++n) _Pragma("unroll") for (int k = 0; k < 2; ++k) dst[n][k] = *(const PG8_LAS bf16x8*)(lds + PG8_SB(b, h) + boff + n * 2048 + k * 1024); } while (0)
#define PG8_MMA(ai, bj, At, Bt) do { __builtin_amdgcn_s_setprio(1); _Pragma("unroll") for (int m = 0; m < 4; ++m) _Pragma("unroll") for (int n = 0; n < 2; ++n) _Pragma("unroll") for (int k = 0; k < 2; ++k) \
        acc[ai][bj][m][n] = __builtin_amdgcn_mfma_f32_16x16x32_bf16(Bt[n][k], At[m][k], acc[ai][bj][m][n], 0, 0, 0); __builtin_amdgcn_s_setprio(0); } while (0)
#define PG8_WAIT_V(n) asm volatile("s_waitcnt vmcnt(" #n ")" ::: "memory")
#define PG8_WAIT_L(n) asm volatile("s_waitcnt lgkmcnt(" #n ")" ::: "memory")
#define PG8_BAR __builtin_amdgcn_s_barrier()
#define PG8_SCHED __builtin_amdgcn_sched_barrier(0)
    Unit cur, nxt; int ui = 0;
    if (!S.next(0, cur)) return;
    f32x4 acc[2][2][4][2];
#pragma unroll
    for (int a = 0; a < 2; ++a)
#pragma unroll
        for (int b = 0; b < 2; ++b)
#pragma unroll
            for (int m = 0; m < 4; ++m)
#pragma unroll
                for (int n = 0; n < 2; ++n) acc[a][b][m][n] = (f32x4){0.f, 0.f, 0.f, 0.f};
    bf16x8 At[4][2], B0[2][2], B1[2][2];
    const char* cA = (const char*)g.A + (size_t)cur.pm * tstep; const char* cB = (const char*)g.Bt + (size_t)cur.pn * tstep;
    S.a_ready(cur);
    if constexpr (SP2) {
        PG8_STAGE(PG8_SB(0, 0), cB, voffB); PG8_STAGE(PG8_SB(0, 1), cB + hstep, voffB); PG8_STAGE(PG8_SA(0, 0), cA, voffA); PG8_STAGE(PG8_SA(0, 1), cA + hstep, voffA);
        if (wr == 1) PG8_BAR;
        PG8_WAIT_V(2); PG8_BAR;
        PG8_STAGE(PG8_SB(1, 0), cB + kstep, voffB); PG8_STAGE(PG8_SA(1, 0), cA + kstep, voffA); PG8_STAGE(PG8_SB(1, 1), cB + hstep + kstep, voffB);
        PG8_WAIT_V(6); PG8_BAR;
    } else {
        PG8_STAGE(PG8_SB(0, 0), cB, voffB); PG8_STAGE(PG8_SA(0, 0), cA, voffA); PG8_STAGE(PG8_SB(0, 1), cB + hstep, voffB); PG8_STAGE(PG8_SA(0, 1), cA + hstep, voffA);
        if (wr == 1) PG8_BAR;
        PG8_WAIT_V(4); PG8_BAR;
        PG8_STAGE(PG8_SB(1, 0), cB + kstep, voffB); PG8_STAGE(PG8_SA(1, 0), cA + kstep, voffA); PG8_STAGE(PG8_SB(1, 1), cB + hstep + kstep, voffB);
        PG8_WAIT_V(6); PG8_BAR;
    }
    for (;;) {
        const bool has_next = S.next(ui + 1, nxt);
        const char* nA = has_next ? (const char*)g.A + (size_t)nxt.pm * tstep : cA; const char* nB = has_next ? (const char*)g.Bt + (size_t)nxt.pn * tstep : cB;
        for (int t = 0; t < nt; t += 2) {
            const bool last = (t == nt - 2);
            const char* a1 = cA + (size_t)(t + 1) * kstep;
            const char* a2 = last ? nA : cA + (size_t)(t + 2) * kstep; const char* b2 = last ? nB : cB + (size_t)(t + 2) * kstep;
            const char* a3 = a2 + kstep; const char* b3 = b2 + kstep;
            if (last && has_next) S.a_ready(nxt);
            if constexpr (SP2) {
            PG8_LDB(B0, 0, 0); PG8_LDB(B1, 0, 1); PG8_SCHED; PG8_LDA(At, 0, 0); PG8_STAGE(PG8_SA(1, 1), a1 + hstep, voffA);
            PG8_WAIT_V(8); PG8_WAIT_L(0); PG8_BAR; PG8_MMA(0, 0, At, B0); PG8_MMA(0, 1, At, B1); PG8_BAR; PG8_SCHED;
            PG8_LDA(At, 0, 1); PG8_STAGE(PG8_SB(0, 0), b2, voffB); PG8_STAGE(PG8_SB(0, 1), b2 + hstep, voffB); PG8_STAGE(PG8_SA(0, 0), a2, voffA);
            PG8_WAIT_V(8); PG8_WAIT_L(0); PG8_BAR; PG8_MMA(1, 0, At, B0); PG8_MMA(1, 1, At, B1); PG8_BAR; PG8_SCHED;
            PG8_LDB(B0, 1, 0); PG8_LDB(B1, 1, 1); PG8_SCHED; PG8_LDA(At, 1, 0); PG8_STAGE(PG8_SA(0, 1), a2 + hstep, voffA);
            PG8_WAIT_V(8); PG8_WAIT_L(0); PG8_BAR; PG8_MMA(0, 0, At, B0); PG8_MMA(0, 1, At, B1); PG8_BAR; PG8_SCHED;
            PG8_LDA(At, 1, 1); PG8_STAGE(PG8_SB(1, 0), b3, voffB); PG8_STAGE(PG8_SB(1, 1), b3 + hstep, voffB); PG8_STAGE(PG8_SA(1, 0), a3, voffA);
            PG8_WAIT_V(8); PG8_WAIT_L(0); PG8_BAR; PG8_MMA(1, 0, At, B0); PG8_MMA(1, 1, At, B1); PG8_BAR; PG8_SCHED;
            } else {
            PG8_LDB(B0, 0, 0); PG8_SCHED; PG8_LDA(At, 0, 0); PG8_STAGE(PG8_SA(1, 1), a1 + hstep, voffA);
            PG8_WAIT_L(8); PG8_BAR; PG8_WAIT_L(0); PG8_MMA(0, 0, At, B0); PG8_BAR; PG8_SCHED;
            PG8_LDB(B1, 0, 1); PG8_STAGE(PG8_SB(0, 0), b2, voffB);
            PG8_BAR; PG8_WAIT_L(0); PG8_MMA(0, 1, At, B1); PG8_BAR;
            PG8_LDA(At, 0, 1); PG8_STAGE(PG8_SA(0, 0), a2, voffA);
            PG8_BAR; PG8_WAIT_L(0); PG8_MMA(1, 0, At, B0); PG8_BAR; PG8_SCHED;
            PG8_STAGE(PG8_SB(0, 1), b2 + hstep, voffB);
            PG8_WAIT_V(6); PG8_BAR; PG8_MMA(1, 1, At, B1); PG8_BAR;
            PG8_LDB(B0, 1, 0); PG8_SCHED; PG8_LDA(At, 1, 0); PG8_STAGE(PG8_SA(0, 1), a2 + hstep, voffA);
            PG8_WAIT_L(8); PG8_BAR; PG8_WAIT_L(0); PG8_MMA(0, 0, At, B0); PG8_BAR; PG8_SCHED;
            PG8_LDB(B1, 1, 1); PG8_STAGE(PG8_SB(1, 0), b3, voffB);
            PG8_BAR; PG8_WAIT_L(0); PG8_MMA(0, 1, At, B1); PG8_BAR;
            PG8_LDA(At, 1, 1); PG8_STAGE(PG8_SA(1, 0), a3, voffA);
            PG8_BAR; PG8_WAIT_L(0); PG8_MMA(1, 0, At, B0); PG8_BAR; PG8_SCHED;
            PG8_STAGE(PG8_SB(1, 1), b3 + hstep, voffB);
            PG8_WAIT_V(6); PG8_BAR; PG8_MMA(1, 1, At, B1); PG8_BAR;
            }
        }
        if constexpr (ALIGN_EPI) { if (wr == 0) PG8_BAR; }
        if constexpr (!Epi::AFTER_DRAIN) { E(acc, cur, wr, wc, fr, fq); S.done(cur); }
        if (!has_next) break;
#pragma unroll
        for (int a = 0; a < 2; ++a)
#pragma unroll
            for (int b = 0; b < 2; ++b)
#pragma unroll
                for (int m = 0; m < 4; ++m)
#pragma unroll
                    for (int n = 0; n < 2; ++n) acc[a][b][m][n] = (f32x4){0.f, 0.f, 0.f, 0.f};
        cur = nxt; cA = nA; cB = nB; ++ui;
        if constexpr (ALIGN_EPI) { if (wr == 1) PG8_BAR; }
    }
    PG8_WAIT_V(0);
    if constexpr (!ALIGN_EPI) { if (wr == 0) PG8_BAR; }
    PG8_BAR;
    if constexpr (Epi::AFTER_DRAIN) { E.fused(acc, cur, wr, wc, fr, fq, lds, wid, lane); S.done(cur); }
#undef PG8_SA
#undef PG8_SB
#undef PG8_STAGE
#undef PG8_LDA
#undef PG8_LDB
#undef PG8_MMA
#undef PG8_WAIT_V
#undef PG8_WAIT_L
#undef PG8_BAR
#undef PG8_SCHED
}
}
constexpr int D_MODEL = 1024, NBATCH = 2, SEQ = 16384, MROWS = NBATCH * SEQ, DFF = 4096, NMEM = 256, MEMROWS = NBATCH * NMEM;
constexpr int NTHREADS = 512, NWAVES = 8;
#define LAS __attribute__((address_space(3)))
#define GAS __attribute__((address_space(1)))
typedef pg8::bf16_t bf16_t;
typedef pg8::bf16x8 bf16x8;
typedef float f32x4 __attribute__((ext_vector_type(4)));
typedef float f32x16 __attribute__((ext_vector_type(16)));
typedef unsigned u32x4 __attribute__((ext_vector_type(4)));
typedef unsigned u32x2 __attribute__((ext_vector_type(2)));
typedef short s16x4 __attribute__((ext_vector_type(4)));
typedef float f32x2_t __attribute__((ext_vector_type(2)));
typedef __bf16 bf16x2_t __attribute__((ext_vector_type(2)));
#define LDS_WAIT() asm volatile("s_waitcnt lgkmcnt(0)" ::: "memory")

constexpr size_t MiB = 1u << 20;
constexpr size_t WS_CTL = 0, CTL_ZERO_BYTES = 65536;
constexpr size_t WS_SS = 1 * MiB;
constexpr size_t WS_C = 3 * MiB;
constexpr size_t WS_MEMB = 4 * MiB;
constexpr size_t WS_MEMKV = 480 * MiB;
constexpr int MEMKV_LD = 2112;
constexpr size_t WS_SSM = 7 * MiB;
constexpr size_t WS_TOT = 7 * MiB + 65536;
constexpr size_t WS_WINA = 8 * MiB;
constexpr size_t WS_WCAT = 15 * MiB;
constexpr size_t WS_WINB1 = 19 * MiB;
constexpr size_t WS_WMEM = 21 * MiB;
constexpr size_t WS_WO = 25 * MiB;
constexpr size_t WS_W1 = 31 * MiB;
constexpr size_t WS_W2 = 63 * MiB;
constexpr size_t WS_HB = 96 * MiB;
constexpr size_t WS_KSH = 160 * MiB, WS_VSH = 192 * MiB;
constexpr size_t WS_A = 224 * MiB;
constexpr size_t WS_MERGED = WS_A + 112 * MiB;
constexpr size_t WS_END = 484 * MiB;
constexpr int CW_KMAX = 16;
constexpr int CW_BAR = 4096;
constexpr int LDS_BYTES = 147456, MISC_OFF = 131072 + 320;

namespace att {
constexpr int KP = 144, VP = 192, KBUF = 64 * KP, VBUF = 64 * VP, CBUF = 256, BUFSZ = KBUF + VBUF + CBUF, FLAG_OFF = 2 * BUFSZ;
constexpr float LOG2E = 1.4426950408889634f;
__device__ __forceinline__ unsigned cvtpk(float lo, float hi) { f32x2_t v = {lo, hi}; bf16x2_t b = __builtin_convertvector(v, bf16x2_t); return __builtin_bit_cast(unsigned, b); }
__device__ __forceinline__ float bf2f(short s) { return __uint_as_float(((unsigned)(unsigned short)s) << 16); }
typedef short v4i16_t __attribute__((ext_vector_type(4)));
__device__ __forceinline__ s16x4 vtr(const LAS unsigned char* p) { return __builtin_bit_cast(s16x4, __builtin_amdgcn_ds_read_tr16_b64_v4i16((LAS v4i16_t*)p)); }

template <int MODE, bool MASKED>
__device__ __forceinline__ void attn_tile(const LAS unsigned char* B, const bf16x8 (&qf)[4], f32x16& o0, f32x16& o1, float& R, float& mrun, float& lrun, bool& wdone,
                                          int s0, int tw, int trow, int hi, unsigned kro, unsigned vro, float qkb, float ct2) {
    f32x16 p0 = {0}, p1 = {0};
#pragma unroll
    for (int c = 0; c < 4; ++c) {
        const bf16x8 a0 = *(const LAS bf16x8*)(B + kro + c * 32);
        const bf16x8 a1 = *(const LAS bf16x8*)(B + kro + 32 * KP + c * 32);
        p0 = __builtin_amdgcn_mfma_f32_32x32x16_bf16(a0, qf[c], p0, 0, 0, 0);
        p1 = __builtin_amdgcn_mfma_f32_32x32x16_bf16(a1, qf[c], p1, 0, 0, 0);
    }
    s16x4 vf0[8], vf1[8];
#pragma unroll
    for (int kd = 0; kd < 8; ++kd) { vf0[kd] = vtr(B + vro + (16 * (kd >> 1)) * VP + 64 * (kd & 1)); vf1[kd] = vtr(B + vro + (16 * (kd >> 1) + 4) * VP + 64 * (kd & 1)); }
    float x[32];
    constexpr bool masked = MASKED;
    const int kb0 = s0 + 8 * hi;
    if (MODE == 0) {
        float om[32];
#pragma unroll
        for (int e = 0; e < 32; ++e) {
            const float ex = __builtin_amdgcn_exp2f((e < 16 ? p0[e & 15] : p1[e & 15]) * LOG2E);
            om[e] = __builtin_amdgcn_rcpf(1.0f + ex);
        }
        if (masked) {
#pragma unroll
            for (int e = 0; e < 32; ++e) if (kb0 + 16 * (e >> 3) + (e & 7) >= trow) om[e] = 1.0f;
        }
#pragma unroll
        for (int e = 0; e < 32; ++e) x[e] = 1.0f - om[e];
        float tot[4], pt[4], off[4];
#pragma unroll
        for (int k = 0; k < 4; ++k) tot[k] = ((om[8 * k] * om[8 * k + 1]) * (om[8 * k + 2] * om[8 * k + 3])) * ((om[8 * k + 4] * om[8 * k + 5]) * (om[8 * k + 6] * om[8 * k + 7]));
#pragma unroll
        for (int k = 0; k < 4; ++k) pt[k] = __shfl_xor(tot[k], 32);
        float suf = R;
#pragma unroll
        for (int k = 3; k >= 0; --k) { off[k] = hi ? suf : suf * pt[k]; suf *= tot[k] * pt[k]; }
        R = suf;
#pragma unroll
        for (int k = 0; k < 4; ++k) {
            float r = off[k];
#pragma unroll
            for (int j = 7; j >= 0; --j) { x[8 * k + j] *= r; r *= om[8 * k + j]; }
        }
        wdone = __all(R < 1e-12f) != 0;
    } else {
        if (MODE == 1) {
#pragma unroll
            for (int k = 0; k < 4; ++k) {
                const LAS f32x4* cp4 = (const LAS f32x4*)(B + KBUF + VBUF + (16 * k + 8 * hi) * 4);
                const f32x4 ca = cp4[0], cb = cp4[1];
#pragma unroll
                for (int j = 0; j < 8; ++j) { const int e = 8 * k + j; x[e] = (e < 16 ? p0[e & 15] : p1[e & 15]) * LOG2E + (ct2 - (j < 4 ? ca[j & 3] : cb[j & 3])); }
            }
            if (masked) {
#pragma unroll
                for (int e = 0; e < 32; ++e) if (kb0 + 16 * (e >> 3) + (e & 7) > trow) x[e] = -1e30f;
            }
        } else {
#pragma unroll
            for (int e = 0; e < 32; ++e) x[e] = (e < 16 ? p0[e & 15] : p1[e & 15]);
        }
        float mx = x[0];
#pragma unroll
        for (int e = 1; e < 32; ++e) mx = fmaxf(mx, x[e]);
        mx = fmaxf(mx, __shfl_xor(mx, 32));
        if (MODE == 2) mx *= LOG2E;
        const float mnew = fmaxf(mrun, mx), sc = __builtin_amdgcn_exp2f(mrun - mnew);
        mrun = mnew;
        float rs = 0.f;
#pragma unroll
        for (int e = 0; e < 32; ++e) { x[e] = __builtin_amdgcn_exp2f(MODE == 2 ? __builtin_fmaf(x[e], LOG2E, -mnew) : x[e] - mnew); rs += x[e]; }
        rs += __shfl_xor(rs, 32);
        lrun = lrun * sc + rs;
#pragma unroll
        for (int r = 0; r < 16; ++r) { o0[r] *= sc; o1[r] *= sc; }
        if (MODE == 1) {
            const float c0 = *(const LAS float*)(B + KBUF + VBUF);
            wdone = __all((qkb + (ct2 - c0) - mrun) < -50.f) != 0;
        }
    }
#pragma unroll
    for (int k = 0; k < 4; ++k) {
        u32x4 pw; pw.x = cvtpk(x[8 * k], x[8 * k + 1]); pw.y = cvtpk(x[8 * k + 2], x[8 * k + 3]); pw.z = cvtpk(x[8 * k + 4], x[8 * k + 5]); pw.w = cvtpk(x[8 * k + 6], x[8 * k + 7]);
        const bf16x8 pf = __builtin_bit_cast(bf16x8, pw);
#pragma unroll
        for (int db = 0; db < 2; ++db) {
            const s16x4 lo = vf0[2 * k + db], h4 = vf1[2 * k + db];
            const bf16x8 vf = {lo[0], lo[1], lo[2], lo[3], h4[0], h4[1], h4[2], h4[3]};
            if (db == 0) o0 = __builtin_amdgcn_mfma_f32_32x32x16_bf16(vf, pf, o0, 0, 0, 0);
            else o1 = __builtin_amdgcn_mfma_f32_32x32x16_bf16(vf, pf, o1, 0, 0, 0);
        }
    }
}

#define ATT_GROUP_BAR() do { asm volatile("s_waitcnt lgkmcnt(0)" ::: "memory"); ++gen; \
        if (lane == 0) (void)__hip_atomic_fetch_add(gbar, 1u, __ATOMIC_RELAXED, __HIP_MEMORY_SCOPE_WORKGROUP); \
        while ((unsigned)__builtin_amdgcn_readfirstlane((int)*(volatile LAS unsigned*)gbar) < 4u * gen) __builtin_amdgcn_s_sleep(1); \
        asm volatile("" ::: "memory"); } while (0)
constexpr int GSZ = 45056;
template <int MODE>
__device__ __forceinline__ void attn_unit(LAS unsigned char* lds, LAS unsigned* gbar, unsigned& gen, const bf16_t* Qp, int ldq, const bf16_t* Kp, int ldk, const bf16_t* Vp, int ldv, bf16_t* Op, int ldo,
                                          const float* cq, const float* ck, float kmax2, int q0, int itile0) {
    int tid_l = threadIdx.x; asm volatile("" : "+v"(tid_l));
    const int tid = tid_l & 255, lane = tid & 63, wid = __builtin_amdgcn_readfirstlane(tid >> 6), r32 = lane & 31, hi = lane >> 5;
    const int tw = q0 + 32 * wid, trow = tw + r32;
    bf16x8 qf[4];
    { const bf16_t* qrow = Qp + (size_t)(32 * wid + r32) * ldq + 8 * hi;
#pragma unroll
      for (int c = 0; c < 4; ++c) qf[c] = *(const GAS bf16x8*)(qrow + 16 * c); }
    float qkb = 0.f, ct2 = 0.f;
    if (MODE == 1) {
        float s = 0.f;
#pragma unroll
        for (int c = 0; c < 4; ++c)
#pragma unroll
            for (int j = 0; j < 8; ++j) { const float v = bf2f(qf[c][j]); s += v * v; }
        s += __shfl_xor(s, 32);
        qkb = sqrtf(s) * kmax2 * 1.001f + 1e-3f;
        ct2 = *(const GAS float*)(cq + (size_t)(32 * wid + r32) * 8) * LOG2E;
    }
    const int srow = tid >> 3, sch = tid & 7;
    const bf16_t* kg = Kp + (size_t)srow * ldk + sch * 8; const bf16_t* vg = Vp + (size_t)srow * ldv + sch * 8;
    const unsigned kwo = srow * KP + sch * 16, vwo = KBUF + srow * VP + sch * 16;
    u32x4 kr0, kr1, vr0, vr1; float cr = 0.f;
#define ATT_LOAD(i) do { kr0 = *(const GAS u32x4*)(kg + (size_t)(i) * 64 * ldk); kr1 = *(const GAS u32x4*)(kg + (size_t)((i) * 64 + 32) * ldk); \
        vr0 = *(const GAS u32x4*)(vg + (size_t)(i) * 64 * ldv); vr1 = *(const GAS u32x4*)(vg + (size_t)((i) * 64 + 32) * ldv); \
        if (MODE == 1) cr = *(const GAS float*)(ck + (size_t)((i) * 64 + (tid & 63)) * 8) * LOG2E; } while (0)
#define ATT_STORE(b) do { *(LAS u32x4*)(lds + (b) * BUFSZ + kwo) = kr0; *(LAS u32x4*)(lds + (b) * BUFSZ + kwo + 32 * KP) = kr1; \
        *(LAS u32x4*)(lds + (b) * BUFSZ + vwo) = vr0; *(LAS u32x4*)(lds + (b) * BUFSZ + vwo + 32 * VP) = vr1; \
        if (MODE == 1 && tid < 64) *(LAS float*)(lds + (b) * BUFSZ + KBUF + VBUF + tid * 4) = cr; } while (0)
    f32x16 o0 = {0}, o1 = {0};
    float R = 1.f, mrun = -1e30f, lrun = 0.f;
    bool wdone = false;
    const int krow = (r32 & 0x13) | ((r32 & 4) << 1) | ((r32 & 8) >> 1);
    const unsigned kro = krow * KP + hi * 16;
    const unsigned vro = KBUF + (8 * hi + ((lane & 15) >> 2)) * VP + (16 * ((lane >> 4) & 1) + 4 * (lane & 3)) * 2;
    int i = itile0, cur = 0;
    ATT_LOAD(i); ATT_STORE(0);
    ATT_GROUP_BAR();
    for (;;) {
        ATT_LOAD((i > 0 ? i - 1 : 0));
        if (!wdone && (MODE == 2 || 64 * i <= tw)) {
            if (MODE != 2 && 64 * i + 64 > tw) attn_tile<MODE, true>(lds + cur * BUFSZ, qf, o0, o1, R, mrun, lrun, wdone, 64 * i, tw, trow, hi, kro, vro, qkb, ct2);
            else attn_tile<MODE, false>(lds + cur * BUFSZ, qf, o0, o1, R, mrun, lrun, wdone, 64 * i, tw, trow, hi, kro, vro, qkb, ct2);
        }
        if (i > 0) ATT_STORE(cur ^ 1);
        if (lane == 0) *(volatile LAS unsigned*)(lds + FLAG_OFF + (cur * 4 + wid) * 4) = wdone ? 0u : 1u;
        ATT_GROUP_BAR();
        if (i == 0) break;
        { const u32x4 fa = *(const LAS u32x4*)(lds + FLAG_OFF + cur * 16); if (((fa.x | fa.y) | (fa.z | fa.w)) == 0u) break; }
        --i; cur ^= 1;
    }
#undef ATT_LOAD
#undef ATT_STORE
    float inv = 1.f;
    if (MODE != 0) inv = 1.0f / lrun;
    bf16_t* orow = Op + (size_t)(32 * wid + r32) * ldo + 4 * hi;
#pragma unroll
    for (int g = 0; g < 4; ++g) {
        u32x2 w0; w0.x = cvtpk(o0[4 * g] * inv, o0[4 * g + 1] * inv); w0.y = cvtpk(o0[4 * g + 2] * inv, o0[4 * g + 3] * inv);
        u32x2 w1; w1.x = cvtpk(o1[4 * g] * inv, o1[4 * g + 1] * inv); w1.y = cvtpk(o1[4 * g + 2] * inv, o1[4 * g + 3] * inv);
        *(GAS u32x2*)(orow + 8 * g) = w0; *(GAS u32x2*)(orow + 32 + 8 * g) = w1;
    }
}
}

#define RLX_AGENT __ATOMIC_RELAXED, __HIP_MEMORY_SCOPE_AGENT
#define XB_TMO      128
#define XB_XCNT(j)  (256  + 64 * (j))
#define XB_XSUB(j)  (1280 + 64 * (j))
#define XB_XGEN(j)  (2304 + 64 * (j))
#define XB_TOP      3328
#define XB_TOPGEN   3392
#define XCD_BAR_WORDS 3456
#define XB_SPIN_CAP (1u << 18)

__device__ __forceinline__ unsigned xb_ld(unsigned* p)              { return __hip_atomic_load(p, __ATOMIC_RELAXED, __HIP_MEMORY_SCOPE_AGENT); }
__device__ __forceinline__ unsigned xb_add(unsigned* p, unsigned v) { return __hip_atomic_fetch_add(p, v, __ATOMIC_RELAXED, __HIP_MEMORY_SCOPE_AGENT); }
__device__ __forceinline__ unsigned xb_xcc_id() { return (unsigned)__builtin_amdgcn_s_getreg((3 << 11) | 20) & 0xFu; }
#define XB_SPIN(cond, bar) do { unsigned _sp = 0; while (cond) { __builtin_amdgcn_s_sleep(1); \
    if ((++_sp & 255u) == 0u) { if (xb_ld(&(bar)[XB_TMO])) break; if (_sp > XB_SPIN_CAP) { atomicAdd(&(bar)[XB_TMO], 1u); break; } } } } while (0)

struct XcdBarrier {
    unsigned* bar; unsigned x;
    volatile LAS unsigned* st;
};

__device__ __forceinline__ XcdBarrier xcd_barrier_post(unsigned* bar, volatile LAS unsigned* st) {
    XcdBarrier b; b.bar = bar; b.x = xb_xcc_id(); b.st = st;
    if (threadIdx.x == 0) (void)xb_add(&bar[XB_XCNT(b.x)], 1u);
    return b;
}
__device__ __forceinline__ void xcd_barrier_complete(unsigned* bar, unsigned x, unsigned& nloc, unsigned& nx) {
    const unsigned G = gridDim.x * gridDim.y * gridDim.z;
    unsigned sum, cnt, mine, sp = 0u;
    for (;;) {
        sum = 0u; cnt = 0u; mine = 0u;
#pragma unroll
        for (unsigned j = 0; j < 16; ++j) { const unsigned c = xb_ld(&bar[XB_XCNT(j)]); sum += c; cnt += (c > 0u) ? 1u : 0u; mine = (j == x) ? c : mine; }
        if (sum == G) break;
        __builtin_amdgcn_s_sleep(1);
        if ((++sp & 255u) == 0u) { if (xb_ld(&bar[XB_TMO])) break; if (sp > XB_SPIN_CAP) { atomicAdd(&bar[XB_TMO], 1u); break; } }
    }
    nloc = mine > 0u ? mine : 1u; nx = cnt > 0u ? cnt : 1u;
}

__device__ __forceinline__ void xcd_barrier(const XcdBarrier& b) {
    asm volatile("s_waitcnt vmcnt(0)" ::: "memory");
    __syncthreads();
    if (threadIdx.x == 0) {
        unsigned* bar = b.bar;
        __builtin_amdgcn_s_waitcnt(0);
        unsigned nloc = b.st[0], nx = b.st[1];
        if (nloc == 0u) { xcd_barrier_complete(bar, b.x, nloc, nx); b.st[0] = nloc; b.st[1] = nx; }
        const unsigned old = xb_add(&bar[XB_XSUB(b.x)], 1u);
        const unsigned gen = old / nloc;
        if (old + 1u == (gen + 1u) * nloc) {
            __builtin_amdgcn_fence(__ATOMIC_RELEASE, "agent");
            asm volatile("s_waitcnt vmcnt(0)" ::: "memory");
            const unsigned og = xb_add(&bar[XB_TOP], 1u);
            const unsigned tg = og / nx;
            if (og + 1u == (tg + 1u) * nx) xb_add(&bar[XB_TOPGEN], 1u);
            else XB_SPIN(xb_ld(&bar[XB_TOPGEN]) == tg, bar);
            __builtin_amdgcn_fence(__ATOMIC_ACQUIRE, "agent");
            xb_add(&bar[XB_XGEN(b.x)], 1u);
            asm volatile("s_waitcnt vmcnt(0)" ::: "memory");
        } else {
            XB_SPIN(xb_ld(&bar[XB_XGEN(b.x)]) == gen, bar);
            __builtin_amdgcn_fence(__ATOMIC_ACQUIRE, "agent");
            asm volatile("s_waitcnt vmcnt(0)" ::: "memory");
        }
    }
    __syncthreads();
}

__device__ __forceinline__ float wave_sum(float v) {
#pragma unroll
    for (int o = 1; o < 64; o <<= 1) v += __shfl_xor(v, o);
    return v;
}
__device__ __forceinline__ unsigned f2bf(float f) { unsigned u = __builtin_bit_cast(unsigned, f); return (u + 0x7fffu + ((u >> 16) & 1u)) >> 16; }
__device__ __forceinline__ unsigned pk2(float lo, float hi) { return f2bf(lo) | (f2bf(hi) << 16); }
__device__ __forceinline__ void conv_item(const float* W, int K, int N, const float* g, bf16_t* WT, int s_lo, int s_hi, LAS float* scr, int item, int lane) {
    const int nblk = (N + 31) / 32, kb = item / nblk, nb = item - kb * nblk, k0 = 64 * kb, n0 = 32 * nb;
    const int nl = n0 + (lane & 31);
    float v[32];
    const float* wp = W + (size_t)(k0 + (lane >> 5)) * N + nl;
#pragma unroll
    for (int i = 0; i < 32; ++i) v[i] = (nl < N) ? *(const GAS float*)(wp + (size_t)(2 * i) * N) : 0.f;
    const int c = lane & 7;
    f32x4 g0 = {1.f, 1.f, 1.f, 1.f}, g1 = {1.f, 1.f, 1.f, 1.f};
    if (g) { g0 = *(const GAS f32x4*)(g + k0 + 8 * c); g1 = *(const GAS f32x4*)(g + k0 + 8 * c + 4); }
#pragma unroll
    for (int i = 0; i < 32; ++i) scr[(2 * i + (lane >> 5)) * 33 + (lane & 31)] = v[i];
    LDS_WAIT(); asm volatile("" ::: "memory");
#pragma unroll
    for (int j = 0; j < 4; ++j) {
        const int n = (lane >> 3) + 8 * j; const LAS float* s = scr + (8 * c) * 33 + n;
        const float cs = ((n0 + n) < s_lo || (n0 + n) >= s_hi) ? 0.125f : 1.0f;
        u32x4 o; o.x = pk2(s[0 * 33] * g0[0] * cs, s[1 * 33] * g0[1] * cs); o.y = pk2(s[2 * 33] * g0[2] * cs, s[3 * 33] * g0[3] * cs);
        o.z = pk2(s[4 * 33] * g1[0] * cs, s[5 * 33] * g1[1] * cs); o.w = pk2(s[6 * 33] * g1[2] * cs, s[7 * 33] * g1[3] * cs);
        if (n0 + n < N) *(GAS u32x4*)(WT + (size_t)(n0 + n) * K + k0 + 8 * c) = o;
    }
    LDS_WAIT(); asm volatile("" ::: "memory");
}
__device__ __forceinline__ void rows2_to_bf16(const float* xrow, bf16_t* orow, float* ssrow, int lane) {
    const GAS f32x4* xr = (const GAS f32x4*)xrow + lane;
    f32x4 v[8]; float s0 = 0.f, s1 = 0.f;
#pragma unroll
    for (int j = 0; j < 8; ++j) v[j] = xr[64 * j];
#pragma unroll
    for (int j = 0; j < 4; ++j) { s0 += (v[j][0] * v[j][0] + v[j][1] * v[j][1]) + (v[j][2] * v[j][2] + v[j][3] * v[j][3]);
                                  s1 += (v[4 + j][0] * v[4 + j][0] + v[4 + j][1] * v[4 + j][1]) + (v[4 + j][2] * v[4 + j][2] + v[4 + j][3] * v[4 + j][3]); }
    GAS u32x2* o8 = (GAS u32x2*)orow + lane;
#pragma unroll
    for (int j = 0; j < 8; ++j) { u32x2 w; w.x = pk2(v[j][0], v[j][1]); w.y = pk2(v[j][2], v[j][3]); o8[64 * j] = w; }
    s0 = wave_sum(s0); s1 = wave_sum(s1);
    if (lane < 8) ssrow[lane] = (lane == 0) ? s0 : (lane == 4 ? s1 : 0.f);
}

struct Params { const float* in[15]; float* out; unsigned char* ws; };

__global__ void __launch_bounds__(NTHREADS, 2) yoco_fwd(Params P) {
    extern __shared__ __attribute__((aligned(16))) unsigned char lds_raw[];
    cg::grid_group grid = cg::this_grid();
    LAS unsigned char* lds = (LAS unsigned char*)lds_raw;
    const int G = gridDim.x, bx = blockIdx.x;
    for (int u = threadIdx.x; u < (LDS_BYTES - 131072) / 4; u += NTHREADS) ((LAS unsigned*)(lds + 131072))[u] = 0u;
    __syncthreads();
    const XcdBarrier xbar = xcd_barrier_post((unsigned*)(P.ws + WS_CTL) + CW_BAR, (volatile LAS unsigned*)(lds + MISC_OFF));
#define WSP(T, off) ((T*)(ws + (off)))
#define g_ctl WSP(unsigned, WS_CTL)
#define g_ss WSP(float, WS_SS)
#define g_cbuf WSP(float, WS_C)
#define g_ssm WSP(float, WS_SSM)
#define g_totb WSP(float, WS_TOT)
#define g_memb WSP(bf16_t, WS_MEMB)
#define g_memkv WSP(bf16_t, WS_MEMKV)
#define g_Wina WSP(bf16_t, WS_WINA)
#define g_Wcat WSP(bf16_t, WS_WCAT)
#define g_Winb1 WSP(bf16_t, WS_WINB1)
#define g_Wmem WSP(bf16_t, WS_WMEM)
#define g_Wo WSP(bf16_t, WS_WO)
#define g_W1 WSP(bf16_t, WS_W1)
#define g_W2 WSP(bf16_t, WS_W2)
#define g_hb WSP(bf16_t, WS_HB)
#define g_Ksh WSP(bf16_t, WS_KSH)
#define g_Vsh WSP(bf16_t, WS_VSH)
#define g_proj WSP(bf16_t, WS_A)
#define g_merged WSP(bf16_t, WS_MERGED)
#define g_hidden WSP(bf16_t, WS_A)
#define g_hout (P.out)

    {
        unsigned char* ws = P.ws;
        const int tid = threadIdx.x, lane = tid & 63, wave = __builtin_amdgcn_readfirstlane(tid >> 6);
        LAS float* scr = (LAS float*)(lds + wave * 16384);
        const int gw = bx * NWAVES + wave, NGW = G * NWAVES;
        for (int mi = 0; mi < 21; ++mi) {
            const float* W; const float* g = nullptr; bf16_t* WT; int K = 1024, N, s_lo = 0, s_hi = 0x7fffffff;
            if (mi < 2) { W = P.in[3] + (size_t)mi * 1024 * 1792; N = 1792; g = P.in[2] + mi * 1024; WT = g_Wina + (size_t)mi * 1792 * 1024; s_lo = 512; s_hi = 1536; }
            else if (mi == 2) { W = P.in[4]; N = 768; g = P.in[2] + 2 * 1024; WT = g_Wcat; s_lo = 768; }
            else if (mi == 3) { W = P.in[12]; N = 1032; g = P.in[11]; WT = g_Wcat + (size_t)768 * 1024; }
            else if (mi == 4) { W = P.in[4] + (size_t)1024 * 768; N = 768; g = P.in[2] + 3 * 1024; WT = g_Winb1; s_lo = 768; }
            else if (mi < 9) { const int l = mi - 5; W = P.in[5] + (size_t)l * 1024 * 512; N = 512; g = P.in[6] + l * 1024; WT = g_Wmem + (size_t)l * 512 * 1024; }
            else if (mi < 13) { const int l = mi - 9; W = P.in[7] + (size_t)l * 768 * 1024; K = 768; N = 1024; WT = g_Wo + (size_t)l * 1024 * 768; }
            else if (mi < 17) { const int l = mi - 13; W = P.in[9] + (size_t)l * 1024 * 4096; N = 4096; g = P.in[8] + l * 1024; WT = g_W1 + (size_t)l * 4096 * 1024; }
            else { const int l = mi - 17; W = P.in[10] + (size_t)l * 4096 * 1024; K = 4096; N = 1024; WT = g_W2 + (size_t)l * 1024 * 4096; }
            const int nitems = (K / 64) * ((N + 31) / 32);
            for (int it = gw; it < nitems; it += NGW) conv_item(W, K, N, g, WT, s_lo, s_hi, scr, it, lane);
        }
        { u32x4* z = (u32x4*)(g_Wcat + (size_t)1800 * 1024); const int nz = 248 * 1024 * 2 / 16; const u32x4 zero = {0u, 0u, 0u, 0u};
          for (int e = gw * 64 + lane; e < nz; e += NGW * 64) z[e] = zero; }
        for (int m = 2 * gw; m < MROWS; m += 2 * NGW) rows2_to_bf16(P.in[0] + (size_t)m * 1024, g_hb + (size_t)m * 1024, g_ss + (size_t)m * 4, lane);
        for (int m = 2 * gw; m < MEMROWS; m += 2 * NGW) rows2_to_bf16(P.in[1] + (size_t)m * 1024, g_memb + (size_t)m * 1024, g_ssm + (size_t)m * 4, lane);
    }
    grid.sync();

    for (int l = 0; l < 4; ++l) {
        for (int sub = 0; sub < 5; ++sub) {
            unsigned char* ws = P.ws; asm volatile("" : "+s"(ws));
            int tid = threadIdx.x; asm volatile("" : "+v"(tid)); const int lane = tid & 63;
            switch (sub) {
            case 0: case 3: {
                for (int pass = (l == 0 && sub == 0) ? 0 : 1; pass < 2; ++pass) {
                    pg8::Gemm g; pg8::EpiProj E; E.ss = g_ss; E.act = 0; E.cat = 0; E.Ksh = g_Ksh; E.Vsh = g_Vsh; E.flog = g_cbuf; int cidx = bx;
                    if (pass == 0) { g.A = g_memb; g.Bt = g_Wmem; g.M = MEMROWS; g.N = 2048; g.K = 1024; E.ss = g_ssm; E.O = g_memkv; E.ldc = MEMKV_LD; cidx = (bx + G / 2) % G; }
                    else if (sub == 3) { g.A = g_hb; g.Bt = g_W1 + (size_t)l * 4096 * 1024; g.M = MROWS; g.N = DFF; g.K = 1024; E.O = g_hidden; E.ldc = DFF; E.act = 1; }
                    else if (l < 2) { g.A = g_hb; g.Bt = g_Wina + (size_t)l * 1792 * 1024; g.M = MROWS; g.N = 1792; g.K = 1024; E.O = g_proj; E.ldc = 1792; }
                    else if (l == 2) { g.A = g_hb; g.Bt = g_Wcat; g.M = MROWS; g.N = 2048; g.K = 1024; E.O = g_proj; E.ldc = 768; E.cat = 1; }
                    else { g.A = g_hb; g.Bt = g_Winb1; g.M = MROWS; g.N = 768; g.K = 1024; E.O = g_proj; E.ldc = 768; }
                    pg8::StaticOrder S; S.init(g.M, g.N, G, cidx);
                    pg8::gemm_phase<pg8::EpiProj, pg8::StaticOrder, true, true>(lds, g, S, E);
                }
            } break;
            case 1: {
                if (l == 2) {
                    LAS float* sb = (LAS float*)lds;
                    for (int ch = bx; ch < MROWS / 128; ch += G) {
                        const int r0 = ch * 128;
                        for (int e = tid; e < 1024; e += NTHREADS) {
                            const float f = g_cbuf[(size_t)r0 * 8 + e] + P.in[13][e & 7];
                            sb[e] = -(fmaxf(-f, 0.f) + log1pf(expf(-fabsf(f))));
                        }
                        __syncthreads();
                        if (tid < 8) { float a = 0.f; for (int r = 0; r < 128; ++r) { a += sb[r * 8 + tid]; sb[r * 8 + tid] = a; } g_totb[ch * 8 + tid] = a; }
                        __syncthreads();
                        for (int e = tid; e < 1024; e += NTHREADS) g_cbuf[(size_t)r0 * 8 + e] = sb[e];
                        float mx = 0.f;
                        for (int e = tid; e < 1024; e += NTHREADS) {
                            const bf16x8* kp = (const bf16x8*)(g_Ksh + (size_t)(r0 + (e >> 3)) * 512 + (e & 7) * 64); float s = 0.f;
#pragma unroll
                            for (int c = 0; c < 8; ++c) { const bf16x8 v = kp[c];
#pragma unroll
                                for (int j = 0; j < 8; ++j) { const float f = att::bf2f(v[j]); s += f * f; } }
                            mx = fmaxf(mx, s);
                        }
                        mx = fmaxf(mx, __shfl_xor(mx, 8)); mx = fmaxf(mx, __shfl_xor(mx, 16)); mx = fmaxf(mx, __shfl_xor(mx, 32));
                        if (lane < 8) atomicMax(g_ctl + CW_KMAX + (r0 >> 14) * 8 + lane, __float_as_uint(mx));
                        __syncthreads();
                    }
                    xcd_barrier(xbar);
                    for (int ch = bx; ch < MROWS / 128; ch += G) {
                        const int r0 = ch * 128, c0 = ch & ~127;
                        {
                          const int hd8 = tid & 7, j = tid >> 3; float a = 0.f;
                          if (c0 + j < ch) a += *(const GAS float*)(g_totb + (size_t)(c0 + j) * 8 + hd8);
                          if (c0 + 64 + j < ch) a += *(const GAS float*)(g_totb + (size_t)(c0 + 64 + j) * 8 + hd8);
                          a += __shfl_xor(a, 8); a += __shfl_xor(a, 16); a += __shfl_xor(a, 32);
                          if (lane < 8) sb[16 + (tid >> 6) * 8 + lane] = a;
                          __syncthreads();
                          if (tid < 8) { float s = 0.f;
#pragma unroll
                              for (int w = 0; w < 8; ++w) s += sb[16 + w * 8 + tid];
                              sb[tid] = s; }
                        }
                        __syncthreads();
                        for (int e = tid; e < 1024; e += NTHREADS) g_cbuf[(size_t)r0 * 8 + e] += sb[e & 7];
                        __syncthreads();
                    }
                    xcd_barrier(xbar);
                }
                {
                    const int ldp = (l < 2) ? 1792 : 768;
                    const int grp = __builtin_amdgcn_readfirstlane(tid >> 8);
                    LAS unsigned char* glds = lds + grp * att::GSZ;
                    LAS unsigned* gbar = (LAS unsigned*)(lds + 131072 + 16) + grp;
                    __syncthreads();
                    unsigned gen = (unsigned)__builtin_amdgcn_readfirstlane((int)*(volatile LAS unsigned*)gbar) >> 2;
                    for (int u = 2 * bx + grp; u < 3072; u += 2 * G) {
                        if (u < 2048) {
                            const int gq = u & 511, kk = u >> 9, cb = gq >> 1, bh = (cb & 7) * 2 + (cb >> 7), qb = (((cb >> 3) & 15) * 2 + (gq & 1)) * 4 + kk, hd = bh & 7, b = bh >> 3, q0 = 128 * qb;
                            const size_t rq = (size_t)b * SEQ + q0, rk = (size_t)b * SEQ;
                            if (l < 2) att::attn_unit<0>(glds, gbar, gen, g_proj + rq * 1792 + hd * 64, 1792, g_proj + rk * 1792 + 512 + hd * 64, 1792, g_proj + rk * 1792 + 1024 + hd * 64, 1792,
                                                         g_merged + rq * 768 + hd * 64, 768, nullptr, nullptr, 0.f, q0, (q0 >> 6) + 1);
                            else { const float kmax2 = sqrtf(__uint_as_float(g_ctl[CW_KMAX + b * 8 + hd])) * att::LOG2E;
                                   att::attn_unit<1>(glds, gbar, gen, g_proj + rq * 768 + hd * 64, 768, g_Ksh + rk * 512 + hd * 64, 512, g_Vsh + rk * 512 + hd * 64, 512,
                                                     g_merged + rq * 768 + hd * 64, 768, g_cbuf + rq * 8 + hd, g_cbuf + rk * 8 + hd, kmax2, q0, (q0 >> 6) + 1); }
                        } else {
                            const int u2 = u - 2048, rb = u2 & 255, hm = u2 >> 8; const size_t rq = (size_t)rb * 128; const int b = (int)(rq >> 14);
                            const bf16_t* qp = g_proj + rq * ldp + ((l < 2) ? 1536 : 512) + hm * 64;
                            const bf16_t* kp = g_memkv + (size_t)(b * NMEM) * MEMKV_LD + l * 512 + hm * 64;
                            att::attn_unit<2>(glds, gbar, gen, qp, ldp, kp, MEMKV_LD, kp + 256, MEMKV_LD, g_merged + rq * 768 + 512 + hm * 64, 768, nullptr, nullptr, 0.f, 0, 3);
                        }
                    }
                    __syncthreads();
                }
            } break;
            default: {
                pg8::Gemm g; g.M = MROWS; g.N = 1024;
                if (sub == 2) { g.A = g_merged; g.Bt = g_Wo + (size_t)l * 1024 * 768; g.K = 768; } else { g.A = g_hidden; g.Bt = g_W2 + (size_t)l * 1024 * 4096; g.K = DFF; }
                pg8::EpiRes E; E.hb = g_hb; E.ss = g_ss; E.red = (LAS float*)(lds + 131072 + 1024);
                pg8::StaticOrder S; S.init(g.M, g.N, G, bx);
                pg8::gemm_phase<pg8::EpiRes, pg8::StaticOrder, true, true>(lds, g, S, E);
            } break;
            }
            xcd_barrier(xbar);
        }
    }
    {
        unsigned char* ws = P.ws; asm volatile("" : "+s"(ws));
        int tid_l = threadIdx.x; asm volatile("" : "+v"(tid_l));
        const int tid = tid_l, lane = tid & 63, wave = __builtin_amdgcn_readfirstlane(tid >> 6);
        const int gw = bx * NWAVES + wave, NGW = G * NWAVES;
        const f32x4* gp = (const f32x4*)P.in[14] + lane;
        f32x4 gv[4];
#pragma unroll
        for (int j = 0; j < 4; ++j) gv[j] = gp[64 * j];
        for (int m = gw; m < MROWS; m += NGW) {
            float s = (lane < 4) ? *(const GAS float*)(g_ss + (size_t)m * 4 + lane) : 0.f;
            s = wave_sum(s);
            const float rs = 1.0f / sqrtf(s * (1.0f / 1024.0f) + pg8::RMS_EPS);
            const GAS u32x2* hr = (const GAS u32x2*)(g_hb + (size_t)m * 1024) + lane;
            GAS f32x4* xr = (GAS f32x4*)(g_hout + (size_t)m * 1024) + lane;
#pragma unroll
            for (int j = 0; j < 4; ++j) { const u32x2 w = hr[64 * j]; const f32x4 v = {pg8::bf_lo(w.x), pg8::bf_hi(w.x), pg8::bf_lo(w.y), pg8::bf_hi(w.y)}; xr[64 * j] = v * rs * gv[j]; }
        }
    }
}

extern "C" void kernel_launch(void* const* d_in, const int* in_sizes, int n_in, void* d_out, int out_size, void* d_ws, size_t ws_size, hipStream_t stream) {
    static int grid = 0;
    if (grid == 0) {
        if (n_in != 15 || in_sizes[0] != MROWS * D_MODEL || out_size != MROWS * D_MODEL || ws_size < WS_END) {
            fprintf(stderr, "kernel_launch: unexpected shapes / workspace (n_in %d, in0 %d, out %d, ws %zu < %zu); nothing launched\n", n_in, n_in > 0 ? in_sizes[0] : -1, out_size, ws_size, (size_t)WS_END);
            grid = -1; return;
        }
        int dev = 0, cus = 0, per_cu = 0;
        if (hipGetDevice(&dev) != hipSuccess || hipDeviceGetAttribute(&cus, hipDeviceAttributeMultiprocessorCount, dev) != hipSuccess) { fprintf(stderr, "kernel_launch: device query failed\n"); grid = -1; return; }
        if (hipFuncSetAttribute((const void*)yoco_fwd, hipFuncAttributeMaxDynamicSharedMemorySize, LDS_BYTES) != hipSuccess) { fprintf(stderr, "kernel_launch: hipFuncSetAttribute failed\n"); grid = -1; return; }
        if (hipOccupancyMaxActiveBlocksPerMultiprocessor(&per_cu, (const void*)yoco_fwd, NTHREADS, LDS_BYTES) != hipSuccess || per_cu < 1) { fprintf(stderr, "kernel_launch: occupancy query says %d\n", per_cu); per_cu = 1; }
        (void)hipGetLastError();
        grid = cus * 1;
    }
    if (grid < 0) return;
    (void)hipMemsetAsync((char*)d_ws + WS_CTL, 0, CTL_ZERO_BYTES, stream);
    Params p{};
    for (int i = 0; i < 15; ++i) p.in[i] = (const float*)d_in[i];
    p.out = (float*)d_out; p.ws = (unsigned char*)d_ws;
    void* args[] = {&p};
    hipError_t e = hipLaunchCooperativeKernel((const void*)yoco_fwd, dim3(grid), dim3(NTHREADS), args, LDS_BYTES, stream);
    if (e != hipSuccess) fprintf(stderr, "kernel_launch: cooperative launch failed: %s (grid %d)\n", hipGetErrorString(e), grid);
}
```

```cpp
#include <hip/hip_runtime.h>
#include <hip/hip_cooperative_groups.h>
#include <cstdio>
#include <cstdint>
namespace cg = cooperative_groups;
namespace pg8 {
#define PG8_LAS __attribute__((address_space(3)))
typedef unsigned short bf16_t;
typedef short bf16x8 __attribute__((ext_vector_type(8)));
typedef float f32x4 __attribute__((ext_vector_type(4)));
typedef unsigned u32x4 __attribute__((ext_vector_type(4)));
constexpr int BM = 256, BK = 64, HALF = 128, HTB = HALF * BK * 2  , STAGE_BYTES = 8 * HTB, NXCD = 8, WGM = 8;

__host__ __device__ __forceinline__ int lds_byte(int r, int c) { const int st = (r >> 4) * 2 + (c >> 5), rr = r & 15, cc = c & 31, ob = rr * 64 + cc * 2; return st * 1024 + (ob ^ (((ob >> 9) & 1) << 5)); }
__host__ __device__ __forceinline__ void stage_rc(int b, int& R, int& C) { const int st = b / 1024, sb = b % 1024, swz = sb ^ (((sb >> 9) & 1) << 5); R = (st >> 1) * 16 + swz / 64; C = (st & 1) * 32 + (swz % 64) / 2; }
__host__ __device__ __forceinline__ int perm32(int rho) { const int n = rho >> 4, i = rho & 15; return 8 * (i >> 2) + 4 * n + (i & 3); }

struct Unit { int pm, pn; };
struct Gemm { const bf16_t* A; const bf16_t* Bt; int M, N, K; };

struct StaticOrder {
    int nM, nN, nwg, G, c;
    __host__ __device__ void init(int M, int N, int G_, int c_) { nM = M / BM; nN = N / BM; nwg = nM * nN; G = G_; c = c_; }
    __host__ __device__ bool next(int i, Unit& u) const {
        const long L = (long)i * G + c; if (L >= nwg) return false;
        int wgid = (int)L; { const int q = nwg / NXCD, r = nwg % NXCD, xcd = wgid % NXCD, off = wgid / NXCD; wgid = (xcd < r ? xcd * (q + 1) : r * (q + 1) + (xcd - r) * q) + off; }
        const int nig = WGM * nN, gid = wgid / nig, fm = gid * WGM, gsz = (nM - fm) < WGM ? (nM - fm) : WGM;
        u.pm = fm + ((wgid % nig) % gsz); u.pn = (wgid % nig) / gsz; return true;
    }
    __device__ __forceinline__ void a_ready(const Unit&) const {}
    __device__ __forceinline__ void done(const Unit&) const {}
};
__device__ __forceinline__ unsigned cvt_pk_bf16(float lo, float hi) { unsigned r; asm volatile("v_cvt_pk_bf16_f32 %0, %1, %2" : "=v"(r) : "v"(lo), "v"(hi)); return r; }
constexpr float RMS_EPS = 1e-6f;
typedef unsigned u32x2 __attribute__((ext_vector_type(2)));
#define PG8_GAS __attribute__((address_space(1)))
struct EpiProj {
    static constexpr bool PERM = true, AFTER_DRAIN = false;
    const float* ss; bf16_t* O; int ldc; int act; int cat; bf16_t* Ksh; bf16_t* Vsh; float* flog;
    __device__ __forceinline__ void operator()(const f32x4 (&acc)[2][2][4][2], const Unit& u, int wr, int wc, int fr, int fq) const {
        const int row0 = u.pm * BM + wr * 64 + fr;
        bf16_t* base = O; int ld = ldc; int colt = u.pn * BM; int kind = 0;
        if (cat) { if (u.pn >= 7) kind = 2; else if (u.pn >= 5) { base = Vsh; ld = 512; colt = (u.pn - 5) * BM; } else if (u.pn >= 3) { base = Ksh; ld = 512; colt = (u.pn - 3) * BM; } }
        const int col0 = colt + wc * 32 + 8 * fq;
        f32x4 sv[2][4];
#pragma unroll
        for (int ai = 0; ai < 2; ++ai)
#pragma unroll
            for (int m = 0; m < 4; ++m) sv[ai][m] = *(const PG8_GAS f32x4*)(ss + (size_t)(row0 + ai * HALF + m * 16) * 4);
#pragma unroll
        for (int ai = 0; ai < 2; ++ai)
#pragma unroll
            for (int m = 0; m < 4; ++m) {
                const int row = row0 + ai * HALF + m * 16;
                const f32x4 sa = sv[ai][m];
                const float t = (sa[0] + sa[1]) + (sa[2] + sa[3]);
                const float rs = __builtin_amdgcn_rsqf(t * (1.0f / 1024.0f) + RMS_EPS);
                if (kind == 2) {
                    if (wc == 0 && fq == 0) { const f32x4 v0 = acc[ai][0][m][0] * rs, v1 = acc[ai][0][m][1] * rs; *(PG8_GAS f32x4*)(flog + (size_t)row * 8) = v0; *(PG8_GAS f32x4*)(flog + (size_t)row * 8 + 4) = v1; }
                } else {
                    bf16_t* rowp = base + (size_t)row * ld + col0;
#pragma unroll
                    for (int bj = 0; bj < 2; ++bj) {
                        f32x4 v0 = acc[ai][bj][m][0] * rs, v1 = acc[ai][bj][m][1] * rs;
                        if (act) {
#pragma unroll
                            for (int j = 0; j < 4; ++j) { const float a = fmaxf(v0[j], 0.f), b = fmaxf(v1[j], 0.f); v0[j] = a * a; v1[j] = b * b; }
                        }
                        u32x4 w; w.x = cvt_pk_bf16(v0[0], v0[1]); w.y = cvt_pk_bf16(v0[2], v0[3]); w.z = cvt_pk_bf16(v1[0], v1[1]); w.w = cvt_pk_bf16(v1[2], v1[3]);
                        *(PG8_GAS u32x4*)(rowp + bj * HALF) = w;
                    }
                }
            }
    }
};
__device__ __forceinline__ float bf_lo(unsigned w) { return __uint_as_float(w << 16); }
__device__ __forceinline__ float bf_hi(unsigned w) { return __uint_as_float(w & 0xffff0000u); }
struct EpiRes {
    static constexpr bool PERM = false, AFTER_DRAIN = false;
    bf16_t* hb; float* ss; PG8_LAS float* red;
    __device__ __forceinline__ void operator()(const f32x4 (&acc)[2][2][4][2], const Unit& u, int wr, int wc, int fr, int fq) const {
        const int col0 = u.pn * BM + wc * 32 + 4 * fq;
#pragma unroll
        for (int ai = 0; ai < 2; ++ai) {
            u32x2 b[4][2][2];
#pragma unroll
            for (int m = 0; m < 4; ++m) {
                const size_t off = (size_t)(u.pm * BM + ai * HALF + wr * 64 + m * 16 + fr) * 1024 + col0;
#pragma unroll
                for (int bj = 0; bj < 2; ++bj)
#pragma unroll
                    for (int n = 0; n < 2; ++n) b[m][bj][n] = *(const PG8_GAS u32x2*)(hb + off + bj * HALF + n * 16);
            }
#pragma unroll
            for (int m = 0; m < 4; ++m) {
                const int rt = ai * HALF + wr * 64 + m * 16 + fr; const size_t off = (size_t)(u.pm * BM + rt) * 1024 + col0; float q = 0.f;
#pragma unroll
                for (int bj = 0; bj < 2; ++bj)
#pragma unroll
                    for (int n = 0; n < 2; ++n) {
                        const f32x4 a = acc[ai][bj][m][n]; const u32x2 bb = b[m][bj][n];
                        u32x2 w; w.x = cvt_pk_bf16(bf_lo(bb.x) + a[0], bf_hi(bb.x) + a[1]); w.y = cvt_pk_bf16(bf_lo(bb.y) + a[2], bf_hi(bb.y) + a[3]);
                        *(PG8_GAS u32x2*)(hb + off + bj * HALF + n * 16) = w;
                        const float o0 = bf_lo(w.x), o1 = bf_hi(w.x), o2 = bf_lo(w.y), o3 = bf_hi(w.y);
                        q += (o0 * o0 + o1 * o1) + (o2 * o2 + o3 * o3);
                    }
                q += __shfl_xor(q, 16); q += __shfl_xor(q, 32);
                if (fq == 0) red[rt * 4 + wc] = q;
            }
            asm volatile("" ::: "memory");
        }
        asm volatile("s_waitcnt lgkmcnt(0)" ::: "memory"); __builtin_amdgcn_s_barrier(); asm volatile("" ::: "memory");
        int t = threadIdx.x; asm volatile("" : "+v"(t));
        if (t < 256) { const f32x4 v = *(const PG8_LAS f32x4*)(red + t * 4); *(PG8_GAS float*)(ss + (size_t)(u.pm * BM + t) * 4 + u.pn) = (v[0] + v[1]) + (v[2] + v[3]); }
    }
};
template <class Epi, class Sched, bool ALIGN_EPI = false, bool SP2 = false>
__device__ __forceinline__ void gemm_phase(PG8_LAS unsigned char* lds, const Gemm g, const Sched& S, const Epi& E) {
    int tid_l = threadIdx.x; asm volatile("" : "+v"(tid_l));
    const int tid = tid_l, wid = __builtin_amdgcn_readfirstlane(tid >> 6), lane = tid & 63, wr = wid >> 2, wc = wid & 3, fr = lane & 15, fq = lane >> 4;
    const int K = g.K, nt = K / BK;
    unsigned voffA[2], voffB[2];
#pragma unroll
    for (int i = 0; i < 2; ++i) { int R, C; stage_rc(tid * 16 + i * 8192, R, C); const int Rb = Epi::PERM ? ((R & ~31) + perm32(R & 31)) : R;
        voffA[i] = (unsigned)(R * K + C) * 2u; voffB[i] = (unsigned)(Rb * K + C) * 2u; }
    const size_t kstep = (size_t)(BK * 2);
    const size_t hstep = (size_t)HALF * K * 2;
    const size_t tstep = 2 * hstep;
    const unsigned ldsw = (unsigned)wid * 1024u;
    const int aoff = lds_byte(wr * 64 + fr, fq * 8), boff = lds_byte(wc * 32 + fr, fq * 8);
#define PG8_SA(b, h) (((b) * 2 + (h)) * HTB)
#define PG8_SB(b, h) ((4 + (b) * 2 + (h)) * HTB)
#define PG8_STAGE(bufoff, gbase, voff) do { _Pragma("unroll") for (int _i = 0; _i < 2; ++_i) \
        __builtin_amdgcn_global_load_lds((const unsigned*)((const char*)(gbase) + (voff)[_i]), (PG8_LAS unsigned*)(lds + (bufoff) + ldsw + _i * 8192), 16, 0, 0); } while (0)
#define PG8_LDA(dst, b, h) do { _Pragma("unroll") for (int m = 0; m < 4; ++m) _Pragma("unroll") for (int k = 0; k < 2; ++k) dst[m][k] = *(const PG8_LAS bf16x8*)(lds + PG8_SA(b, h) + aoff + m * 2048 + k * 1024); } while (0)
#define PG8_LDB(dst, b, h) do { _Pragma("unroll") for (int n = 0; n < 2; ++n) _Pragma("unroll") for (int k = 0; k < 2; ++k) dst[n][k] = *(const PG8_LAS bf16x8*)(lds + PG8_SB(b, h) + boff + n * 2048 + k * 1024); } while (0)
#define PG8_MMA(ai, bj, At, Bt) do { __builtin_amdgcn_s_setprio(1); _Pragma("unroll") for (int m = 0; m < 4; ++m) _Pragma("unroll") for (int n = 0; n < 2; ++n) _Pragma("unroll") for (int k = 0; k < 2; ++k) \
        acc[ai][bj][m][n] = __builtin_amdgcn_mfma_f32_16x16x32_bf16(Bt[n][k], At[m][k], acc[ai][bj][m][n], 0, 0, 0); __builtin_amdgcn_s_setprio(0); } while (0)
#define PG8_WAIT_V(n) asm volatile("s_waitcnt vmcnt(" #n ")" ::: "memory")
#define PG8_WAIT_L(n) asm volatile("s_waitcnt lgkmcnt(" #n ")" ::: "memory")
#define PG8_BAR __builtin_amdgcn_s_barrier()
#define PG8_SCHED __builtin_amdgcn_sched_barrier(0)
    Unit cur, nxt; int ui = 0;
    if (!S.next(0, cur)) return;
    f32x4 acc[2][2][4][2];
#pragma unroll
    for (int a = 0; a < 2; ++a)
#pragma unroll
        for (int b = 0; b < 2; ++b)
#pragma unroll
            for (int m = 0; m < 4; ++m)
#pragma unroll
                for (int n = 0; n < 2; ++n) acc[a][b][m][n] = (f32x4){0.f, 0.f, 0.f, 0.f};
    bf16x8 At[4][2], B0[2][2], B1[2][2];
    const char* cA = (const char*)g.A + (size_t)cur.pm * tstep; const char* cB = (const char*)g.Bt + (size_t)cur.pn * tstep;
    S.a_ready(cur);
    if constexpr (SP2) {
        PG8_STAGE(PG8_SB(0, 0), cB, voffB); PG8_STAGE(PG8_SB(0, 1), cB + hstep, voffB); PG8_STAGE(PG8_SA(0, 0), cA, voffA); PG8_STAGE(PG8_SA(0, 1), cA + hstep, voffA);
        if (wr == 1) PG8_BAR;
        PG8_WAIT_V(2); PG8_BAR;
        PG8_STAGE(PG8_SB(1, 0), cB + kstep, voffB); PG8_STAGE(PG8_SA(1, 0), cA + kstep, voffA); PG8_STAGE(PG8_SB(1, 1), cB + hstep + kstep, voffB);
        PG8_WAIT_V(6); PG8_BAR;
    } else {
        PG8_STAGE(PG8_SB(0, 0), cB, voffB); PG8_STAGE(PG8_SA(0, 0), cA, voffA); PG8_STAGE(PG8_SB(0, 1), cB + hstep, voffB); PG8_STAGE(PG8_SA(0, 1), cA + hstep, voffA);
        if (wr == 1) PG8_BAR;
        PG8_WAIT_V(4); PG8_BAR;
        PG8_STAGE(PG8_SB(1, 0), cB + kstep, voffB); PG8_STAGE(PG8_SA(1, 0), cA + kstep, voffA); PG8_STAGE(PG8_SB(1, 1), cB + hstep + kstep, voffB);
        PG8_WAIT_V(6); PG8_BAR;
    }
    for (;;) {
        const bool has_next = S.next(ui + 1, nxt);
        const char* nA = has_next ? (const char*)g.A + (size_t)nxt.pm * tstep : cA; const char* nB = has_next ? (const char*)g.Bt + (size_t)nxt.pn * tstep : cB;
        for (int t = 0; t < nt; t += 2) {
            const bool last = (t == nt - 2);
            const char* a1 = cA + (size_t)(t + 1) * kstep;
            const char* a2 = last ? nA : cA + (size_t)(t + 2) * kstep; const char* b2 = last ? nB : cB + (size_t)(t + 2) * kstep;
            const char* a3 = a2 + kstep; const char* b3 = b2 + kstep;
            if (last && has_next) S.a_ready(nxt);
            if constexpr (SP2) {
            PG8_LDB(B0, 0, 0); PG8_LDB(B1, 0, 1); PG8_SCHED; PG8_LDA(At, 0, 0); PG8_STAGE(PG8_SA(1, 1), a1 + hstep, voffA);
            PG8_WAIT_V(8); PG8_WAIT_L(0); PG8_BAR; PG8_MMA(0, 0, At, B0); PG8_MMA(0, 1, At, B1); PG8_BAR; PG8_SCHED;
            PG8_LDA(At, 0, 1); PG8_STAGE(PG8_SB(0, 0), b2, voffB); PG8_STAGE(PG8_SB(0, 1), b2 + hstep, voffB); PG8_STAGE(PG8_SA(0, 0), a2, voffA);
            PG8_WAIT_V(8); PG8_WAIT_L(0); PG8_BAR; PG8_MMA(1, 0, At, B0); PG8_MMA(1, 1, At, B1); PG8_BAR; PG8_SCHED;
            PG8_LDB(B0, 1, 0); PG8_LDB(B1, 1, 1); PG8_SCHED; PG8_LDA(At, 1, 0); PG8_STAGE(PG8_SA(0, 1), a2 + hstep, voffA);
            PG8_WAIT_V(8); PG8_WAIT_L(0); PG8_BAR; PG8_MMA(0, 0, At, B0); PG8_MMA(0, 1, At, B1); PG8_BAR; PG8_SCHED;
            PG8_LDA(At, 1, 1); PG8_STAGE(PG8_SB(1, 0), b3, voffB); PG8_STAGE(PG8_SB(1, 1), b3 + hstep, voffB); PG8_STAGE(PG8_SA(1, 0), a3, voffA);
            PG8_WAIT_V(8); PG8_WAIT_L(0); PG8_BAR; PG8_MMA(1, 0, At, B0); PG8_MMA(1, 1, At, B1); PG8_BAR; PG8_SCHED;
            } else {
            PG8_LDB(B0, 0, 0); PG8_SCHED; PG8_LDA(At, 0, 0); PG8_STAGE(PG8_SA(1, 1), a1 + hstep, voffA);
            PG8_WAIT_L(8); PG8_BAR; PG8_WAIT_L(0); PG8_MMA(0, 0, At, B0); PG8_BAR; PG8_SCHED;
            PG8_LDB(B1, 0, 1); PG8_STAGE(PG8_SB(0, 0), b2, voffB);
            PG8_BAR; PG8_WAIT_L(0); PG8_MMA(0, 1, At, B1); PG8_BAR;
            PG8_LDA(At, 0, 1); PG8_STAGE(PG8_SA(0, 0), a2, voffA);
            PG8_BAR; PG8_WAIT_L(0); PG8_MMA(1, 0, At, B0); PG8_BAR; PG8_SCHED;
            PG8_STAGE(PG8_SB(0, 1), b2 + hstep, voffB);
            PG8_WAIT_V(6); PG8_BAR; PG8_MMA(1, 1, At, B1); PG8_BAR;
            PG8_LDB(B0, 1, 0); PG8_SCHED; PG8_LDA(At, 1, 0); PG8_STAGE(PG8_SA(0, 1), a2 + hstep, voffA);
            PG8_WAIT_L(8); PG8_BAR; PG8_WAIT_L(0); PG8_MMA(0, 0, At, B0); PG8_BAR; PG8_SCHED;
            PG8_LDB(B1, 1, 1); PG8_STAGE(PG8_SB(1, 0), b3, voffB);
            PG8_BAR; PG8_WAIT_L(0); PG8_MMA(0, 1, At, B1); PG8_BAR;
            PG8_LDA(At, 1, 1); PG8_STAGE(PG8_SA(1, 0), a3, voffA);
            PG8_BAR; PG8_WAIT_L(0); PG8_MMA(1, 0, At, B0); PG8_BAR; PG8_SCHED;
            PG8_STAGE(PG8_SB(1, 1), b3 + hstep, voffB);
            PG8_WAIT_V(6); PG8_BAR; PG8_MMA(1, 1, At, B1); PG8_BAR;
            }
        }
        if constexpr (ALIGN_EPI) { if (wr == 0) PG8_BAR; }
        if constexpr (!Epi::AFTER_DRAIN) { E(acc, cur, wr, wc, fr, fq); S.done(cur); }
        if (!has_next) break;
#pragma unroll
        for (int a = 0; a < 2; ++a)
#pragma unroll
            for (int b = 0; b < 2; ++b)
#pragma unroll
                for (int m = 0; m < 4; ++m)
#pragma unroll
                    for (int n = 0; n < 2; ++n) acc[a][b][m][n] = (f32x4){0.f, 0.f, 0.f, 0.f};
        cur = nxt; cA = nA; cB = nB; ++ui;
        if constexpr (ALIGN_EPI) { if (wr == 1) PG8_BAR; }
    }
    PG8_WAIT_V(0);
    if constexpr (!ALIGN_EPI) { if (wr == 0) PG8_BAR; }
    PG8_BAR;
    if constexpr (Epi::AFTER_DRAIN) { E.fused(acc, cur, wr, wc, fr, fq, lds, wid, lane); S.done(cur); }
#undef PG8_SA
#undef PG8_SB
#undef PG8_STAGE
#undef PG8_LDA
#undef PG8_LDB
#undef PG8_MMA
#undef PG8_WAIT_V
#undef PG8_WAIT_L
#undef PG8_BAR
#undef PG8_SCHED
}
}
constexpr int D_MODEL = 1024, NBATCH = 2, SEQ = 16384, MROWS = NBATCH * SEQ, DFF = 4096, NMEM = 256, MEMROWS = NBATCH * NMEM;
constexpr int NTHREADS = 512, NWAVES = 8;
#define LAS __attribute__((address_space(3)))
#define GAS __attribute__((address_space(1)))
typedef pg8::bf16_t bf16_t;
typedef pg8::bf16x8 bf16x8;
typedef float f32x4 __attribute__((ext_vector_type(4)));
typedef float f32x16 __attribute__((ext_vector_type(16)));
typedef unsigned u32x4 __attribute__((ext_vector_type(4)));
typedef unsigned u32x2 __attribute__((ext_vector_type(2)));
typedef short s16x4 __attribute__((ext_vector_type(4)));
typedef float f32x2_t __attribute__((ext_vector_type(2)));
typedef __bf16 bf16x2_t __attribute__((ext_vector_type(2)));
#define LDS_WAIT() asm volatile("s_waitcnt lgkmcnt(0)" ::: "memory")

constexpr size_t MiB = 1u << 20;
constexpr size_t WS_CTL = 0, CTL_ZERO_BYTES = 65536;
constexpr size_t WS_SS = 1 * MiB;
constexpr size_t WS_C = 3 * MiB;
constexpr size_t WS_MEMB = 4 * MiB;
constexpr size_t WS_MEMKV = 480 * MiB;
constexpr int MEMKV_LD = 2112;
constexpr size_t WS_SSM = 7 * MiB;
constexpr size_t WS_TOT = 7 * MiB + 65536;
constexpr size_t WS_WINA = 8 * MiB;
constexpr size_t WS_WCAT = 15 * MiB;
constexpr size_t WS_WINB1 = 19 * MiB;
constexpr size_t WS_WMEM = 21 * MiB;
constexpr size_t WS_WO = 25 * MiB;
constexpr size_t WS_W1 = 31 * MiB;
constexpr size_t WS_W2 = 63 * MiB;
constexpr size_t WS_HB = 96 * MiB;
constexpr size_t WS_KSH = 160 * MiB, WS_VSH = 192 * MiB;
constexpr size_t WS_A = 224 * MiB;
constexpr size_t WS_MERGED = WS_A + 112 * MiB;
constexpr size_t WS_END = 484 * MiB;
constexpr int CW_KMAX = 16;
constexpr int CW_BAR = 4096;
constexpr int LDS_BYTES = 147456, MISC_OFF = 131072 + 320;

namespace att {
constexpr int KP = 144, VP = 192, KBUF = 64 * KP, VBUF = 64 * VP, CBUF = 256, BUFSZ = KBUF + VBUF + CBUF, FLAG_OFF = 2 * BUFSZ;
constexpr float LOG2E = 1.4426950408889634f;
__device__ __forceinline__ unsigned cvtpk(float lo, float hi) { f32x2_t v = {lo, hi}; bf16x2_t b = __builtin_convertvector(v, bf16x2_t); return __builtin_bit_cast(unsigned, b); }
__device__ __forceinline__ float bf2f(short s) { return __uint_as_float(((unsigned)(unsigned short)s) << 16); }
typedef short v4i16_t __attribute__((ext_vector_type(4)));
__device__ __forceinline__ s16x4 vtr(const LAS unsigned char* p) { return __builtin_bit_cast(s16x4, __builtin_amdgcn_ds_read_tr16_b64_v4i16((LAS v4i16_t*)p)); }

template <int MODE, bool MASKED>
__device__ __forceinline__ void attn_tile(const LAS unsigned char* B, const bf16x8 (&qf)[4], f32x16& o0, f32x16& o1, float& R, float& mrun, float& lrun, bool& wdone,
                                          int s0, int tw, int trow, int hi, unsigned kro, unsigned vro, float qkb, float ct2) {
    f32x16 p0 = {0}, p1 = {0};
#pragma unroll
    for (int c = 0; c < 4; ++c) {
        const bf16x8 a0 = *(const LAS bf16x8*)(B + kro + c * 32);
        const bf16x8 a1 = *(const LAS bf16x8*)(B + kro + 32 * KP + c * 32);
        p0 = __builtin_amdgcn_mfma_f32_32x32x16_bf16(a0, qf[c], p0, 0, 0, 0);
        p1 = __builtin_amdgcn_mfma_f32_32x32x16_bf16(a1, qf[c], p1, 0, 0, 0);
    }
    s16x4 vf0[8], vf1[8];
#pragma unroll
    for (int kd = 0; kd < 8; ++kd) { vf0[kd] = vtr(B + vro + (16 * (kd >> 1)) * VP + 64 * (kd & 1)); vf1[kd] = vtr(B + vro + (16 * (kd >> 1) + 4) * VP + 64 * (kd & 1)); }
    float x[32];
    constexpr bool masked = MASKED;
    const int kb0 = s0 + 8 * hi;
    if (MODE == 0) {
        float om[32];
#pragma unroll
        for (int e = 0; e < 32; ++e) {
            const float ex = __builtin_amdgcn_exp2f((e < 16 ? p0[e & 15] : p1[e & 15]) * LOG2E);
            om[e] = __builtin_amdgcn_rcpf(1.0f + ex);
        }
        if (masked) {
#pragma unroll
            for (int e = 0; e < 32; ++e) if (kb0 + 16 * (e >> 3) + (e & 7) >= trow) om[e] = 1.0f;
        }
#pragma unroll
        for (int e = 0; e < 32; ++e) x[e] = 1.0f - om[e];
        float tot[4], pt[4], off[4];
#pragma unroll
        for (int k = 0; k < 4; ++k) tot[k] = ((om[8 * k] * om[8 * k + 1]) * (om[8 * k + 2] * om[8 * k + 3])) * ((om[8 * k + 4] * om[8 * k + 5]) * (om[8 * k + 6] * om[8 * k + 7]));
#pragma unroll
        for (int k = 0; k < 4; ++k) pt[k] = __shfl_xor(tot[k], 32);
        float suf = R;
#pragma unroll
        for (int k = 3; k >= 0; --k) { off[k] = hi ? suf : suf * pt[k]; suf *= tot[k] * pt[k]; }
        R = suf;
#pragma unroll
        for (int k = 0; k < 4; ++k) {
            float r = off[k];
#pragma unroll
            for (int j = 7; j >= 0; --j) { x[8 * k + j] *= r; r *= om[8 * k + j]; }
        }
        wdone = __all(R < 1e-12f) != 0;
    } else {
        if (MODE == 1) {
#pragma unroll
            for (int k = 0; k < 4; ++k) {
                const LAS f32x4* cp4 = (const LAS f32x4*)(B + KBUF + VBUF + (16 * k + 8 * hi) * 4);
                const f32x4 ca = cp4[0], cb = cp4[1];
#pragma unroll
                for (int j = 0; j < 8; ++j) { const int e = 8 * k + j; x[e] = (e < 16 ? p0[e & 15] : p1[e & 15]) * LOG2E + (ct2 - (j < 4 ? ca[j & 3] : cb[j & 3])); }
            }
            if (masked) {
#pragma unroll
                for (int e = 0; e < 32; ++e) if (kb0 + 16 * (e >> 3) + (e & 7) > trow) x[e] = -1e30f;
            }
        } else {
#pragma unroll
            for (int e = 0; e < 32; ++e) x[e] = (e < 16 ? p0[e & 15] : p1[e & 15]);
        }
        float mx = x[0];
#pragma unroll
        for (int e = 1; e < 32; ++e) mx = fmaxf(mx, x[e]);
        mx = fmaxf(mx, __shfl_xor(mx, 32));
        if (MODE == 2) mx *= LOG2E;
        const float mnew = fmaxf(mrun, mx), sc = __builtin_amdgcn_exp2f(mrun - mnew);
        mrun = mnew;
        float rs = 0.f;
#pragma unroll
        for (int e = 0; e < 32; ++e) { x[e] = __builtin_amdgcn_exp2f(MODE == 2 ? __builtin_fmaf(x[e], LOG2E, -mnew) : x[e] - mnew); rs += x[e]; }
        rs += __shfl_xor(rs, 32);
        lrun = lrun * sc + rs;
#pragma unroll
        for (int r = 0; r < 16; ++r) { o0[r] *= sc; o1[r] *= sc; }
        if (MODE == 1) {
            const float c0 = *(const LAS float*)(B + KBUF + VBUF);
            wdone = __all((qkb + (ct2 - c0) - mrun) < -50.f) != 0;
        }
    }
#pragma unroll
    for (int k = 0; k < 4; ++k) {
        u32x4 pw; pw.x = cvtpk(x[8 * k], x[8 * k + 1]); pw.y = cvtpk(x[8 * k + 2], x[8 * k + 3]); pw.z = cvtpk(x[8 * k + 4], x[8 * k + 5]); pw.w = cvtpk(x[8 * k + 6], x[8 * k + 7]);
        const bf16x8 pf = __builtin_bit_cast(bf16x8, pw);
#pragma unroll
        for (int db = 0; db < 2; ++db) {
            const s16x4 lo = vf0[2 * k + db], h4 = vf1[2 * k + db];
            const bf16x8 vf = {lo[0], lo[1], lo[2], lo[3], h4[0], h4[1], h4[2], h4[3]};
            if (db == 0) o0 = __builtin_amdgcn_mfma_f32_32x32x16_bf16(vf, pf, o0, 0, 0, 0);
            else o1 = __builtin_amdgcn_mfma_f32_32x32x16_bf16(vf, pf, o1, 0, 0, 0);
        }
    }
}

#define ATT_GROUP_BAR() do { asm volatile("s_waitcnt lgkmcnt(0)" ::: "memory"); ++gen; \
        if (lane == 0) (void)__hip_atomic_fetch_add(gbar, 1u, __ATOMIC_RELAXED, __HIP_MEMORY_SCOPE_WORKGROUP); \
        while ((unsigned)__builtin_amdgcn_readfirstlane((int)*(volatile LAS unsigned*)gbar) < 4u * gen) __builtin_amdgcn_s_sleep(1); \
        asm volatile("" ::: "memory"); } while (0)
constexpr int GSZ = 45056;
template <int MODE>
__device__ __forceinline__ void attn_unit(LAS unsigned char* lds, LAS unsigned* gbar, unsigned& gen, const bf16_t* Qp, int ldq, const bf16_t* Kp, int ldk, const bf16_t* Vp, int ldv, bf16_t* Op, int ldo,
                                          const float* cq, const float* ck, float kmax2, int q0, int itile0) {
    int tid_l = threadIdx.x; asm volatile("" : "+v"(tid_l));
    const int tid = tid_l & 255, lane = tid & 63, wid = __builtin_amdgcn_readfirstlane(tid >> 6), r32 = lane & 31, hi = lane >> 5;
    const int tw = q0 + 32 * wid, trow = tw + r32;
    bf16x8 qf[4];
    { const bf16_t* qrow = Qp + (size_t)(32 * wid + r32) * ldq + 8 * hi;
#pragma unroll
      for (int c = 0; c < 4; ++c) qf[c] = *(const GAS bf16x8*)(qrow + 16 * c); }
    float qkb = 0.f, ct2 = 0.f;
    if (MODE == 1) {
        float s = 0.f;
#pragma unroll
        for (int c = 0; c < 4; ++c)
#pragma unroll
            for (int j = 0; j < 8; ++j) { const float v = bf2f(qf[c][j]); s += v * v; }
        s += __shfl_xor(s, 32);
        qkb = sqrtf(s) * kmax2 * 1.001f + 1e-3f;
        ct2 = *(const GAS float*)(cq + (size_t)(32 * wid + r32) * 8) * LOG2E;
    }
    const int srow = tid >> 3, sch = tid & 7;
    const bf16_t* kg = Kp + (size_t)srow * ldk + sch * 8; const bf16_t* vg = Vp + (size_t)srow * ldv + sch * 8;
    const unsigned kwo = srow * KP + sch * 16, vwo = KBUF + srow * VP + sch * 16;
    u32x4 kr0, kr1, vr0, vr1; float cr = 0.f;
#define ATT_LOAD(i) do { kr0 = *(const GAS u32x4*)(kg + (size_t)(i) * 64 * ldk); kr1 = *(const GAS u32x4*)(kg + (size_t)((i) * 64 + 32) * ldk); \
        vr0 = *(const GAS u32x4*)(vg + (size_t)(i) * 64 * ldv); vr1 = *(const GAS u32x4*)(vg + (size_t)((i) * 64 + 32) * ldv); \
        if (MODE == 1) cr = *(const GAS float*)(ck + (size_t)((i) * 64 + (tid & 63)) * 8) * LOG2E; } while (0)
#define ATT_STORE(b) do { *(LAS u32x4*)(lds + (b) * BUFSZ + kwo) = kr0; *(LAS u32x4*)(lds + (b) * BUFSZ + kwo + 32 * KP) = kr1; \
        *(LAS u32x4*)(lds + (b) * BUFSZ + vwo) = vr0; *(LAS u32x4*)(lds + (b) * BUFSZ + vwo + 32 * VP) = vr1; \
        if (MODE == 1 && tid < 64) *(LAS float*)(lds + (b) * BUFSZ + KBUF + VBUF + tid * 4) = cr; } while (0)
    f32x16 o0 = {0}, o1 = {0};
    float R = 1.f, mrun = -1e30f, lrun = 0.f;
    bool wdone = false;
    const int krow = (r32 & 0x13) | ((r32 & 4) << 1) | ((r32 & 8) >> 1);
    const unsigned kro = krow * KP + hi * 16;
    const unsigned vro = KBUF + (8 * hi + ((lane & 15) >> 2)) * VP + (16 * ((lane >> 4) & 1) + 4 * (lane & 3)) * 2;
    int i = itile0, cur = 0;
    ATT_LOAD(i); ATT_STORE(0);
    ATT_GROUP_BAR();
    for (;;) {
        ATT_LOAD((i > 0 ? i - 1 : 0));
        if (!wdone && (MODE == 2 || 64 * i <= tw)) {
            if (MODE != 2 && 64 * i + 64 > tw) attn_tile<MODE, true>(lds + cur * BUFSZ, qf, o0, o1, R, mrun, lrun, wdone, 64 * i, tw, trow, hi, kro, vro, qkb, ct2);
            else attn_tile<MODE, false>(lds + cur * BUFSZ, qf, o0, o1, R, mrun, lrun, wdone, 64 * i, tw, trow, hi, kro, vro, qkb, ct2);
        }
        if (i > 0) ATT_STORE(cur ^ 1);
        if (lane == 0) *(volatile LAS unsigned*)(lds + FLAG_OFF + (cur * 4 + wid) * 4) = wdone ? 0u : 1u;
        ATT_GROUP_BAR();
        if (i == 0) break;
        { const u32x4 fa = *(const LAS u32x4*)(lds + FLAG_OFF + cur * 16); if (((fa.x | fa.y) | (fa.z | fa.w)) == 0u) break; }
        --i; cur ^= 1;
    }
#undef ATT_LOAD
#undef ATT_STORE
    float inv = 1.f;
    if (MODE != 0) inv = 1.0f / lrun;
    bf16_t* orow = Op + (size_t)(32 * wid + r32) * ldo + 4 * hi;
#pragma unroll
    for (int g = 0; g < 4; ++g) {
        u32x2 w0; w0.x = cvtpk(o0[4 * g] * inv, o0[4 * g + 1] * inv); w0.y = cvtpk(o0[4 * g + 2] * inv, o0[4 * g + 3] * inv);
        u32x2 w1; w1.x = cvtpk(o1[4 * g] * inv, o1[4 * g + 1] * inv); w1.y = cvtpk(o1[4 * g + 2] * inv, o1[4 * g + 3] * inv);
        *(GAS u32x2*)(orow + 8 * g) = w0; *(GAS u32x2*)(orow + 32 + 8 * g) = w1;
    }
}
}

#define RLX_AGENT __ATOMIC_RELAXED, __HIP_MEMORY_SCOPE_AGENT
#define XB_TMO      128
#define XB_XCNT(j)  (256  + 64 * (j))
#define XB_XSUB(j)  (1280 + 64 * (j))
#define XB_XGEN(j)  (2304 + 64 * (j))
#define XB_TOP      3328
#define XB_TOPGEN   3392
#define XCD_BAR_WORDS 3456
#define XB_SPIN_CAP (1u << 18)

__device__ __forceinline__ unsigned xb_ld(unsigned* p)              { return __hip_atomic_load(p, __ATOMIC_RELAXED, __HIP_MEMORY_SCOPE_AGENT); }
__device__ __forceinline__ unsigned xb_add(unsigned* p, unsigned v) { return __hip_atomic_fetch_add(p, v, __ATOMIC_RELAXED, __HIP_MEMORY_SCOPE_AGENT); }
__device__ __forceinline__ unsigned xb_xcc_id() { return (unsigned)__builtin_amdgcn_s_getreg((3 << 11) | 20) & 0xFu; }
#define XB_SPIN(cond, bar) do { unsigned _sp = 0; while (cond) { __builtin_amdgcn_s_sleep(1); \
    if ((++_sp & 255u) == 0u) { if (xb_ld(&(bar)[XB_TMO])) break; if (_sp > XB_SPIN_CAP) { atomicAdd(&(bar)[XB_TMO], 1u); break; } } } } while (0)

struct XcdBarrier {
    unsigned* bar; unsigned x;
    volatile LAS unsigned* st;
};

__device__ __forceinline__ XcdBarrier xcd_barrier_post(unsigned* bar, volatile LAS unsigned* st) {
    XcdBarrier b; b.bar = bar; b.x = xb_xcc_id(); b.st = st;
    if (threadIdx.x == 0) (void)xb_add(&bar[XB_XCNT(b.x)], 1u);
    return b;
}
__device__ __forceinline__ void xcd_barrier_complete(unsigned* bar, unsigned x, unsigned& nloc, unsigned& nx) {
    const unsigned G = gridDim.x * gridDim.y * gridDim.z;
    unsigned sum, cnt, mine, sp = 0u;
    for (;;) {
        sum = 0u; cnt = 0u; mine = 0u;
#pragma unroll
        for (unsigned j = 0; j < 16; ++j) { const unsigned c = xb_ld(&bar[XB_XCNT(j)]); sum += c; cnt += (c > 0u) ? 1u : 0u; mine = (j == x) ? c : mine; }
        if (sum == G) break;
        __builtin_amdgcn_s_sleep(1);
        if ((++sp & 255u) == 0u) { if (xb_ld(&bar[XB_TMO])) break; if (sp > XB_SPIN_CAP) { atomicAdd(&bar[XB_TMO], 1u); break; } }
    }
    nloc = mine > 0u ? mine : 1u; nx = cnt > 0u ? cnt : 1u;
}

__device__ __forceinline__ void xcd_barrier(const XcdBarrier& b_in) {
    XcdBarrier b = b_in; asm volatile("" : "+s"(b.bar), "+s"(b.x));
    asm volatile("s_waitcnt vmcnt(0)" ::: "memory");
    __syncthreads();
    if (threadIdx.x == 0) {
        unsigned* bar = b.bar;
        __builtin_amdgcn_s_waitcnt(0);
        unsigned nloc = b.st[0], nx = b.st[1];
        if (nloc == 0u) { xcd_barrier_complete(bar, b.x, nloc, nx); b.st[0] = nloc; b.st[1] = nx; }
        const unsigned old = xb_add(&bar[XB_XSUB(b.x)], 1u);
        const unsigned gen = old / nloc;
        if (old + 1u == (gen + 1u) * nloc) {
            __builtin_amdgcn_fence(__ATOMIC_RELEASE, "agent");
            asm volatile("s_waitcnt vmcnt(0)" ::: "memory");
            const unsigned og = xb_add(&bar[XB_TOP], 1u);
            const unsigned tg = og / nx;
            if (og + 1u == (tg + 1u) * nx) xb_add(&bar[XB_TOPGEN], 1u);
            else XB_SPIN(xb_ld(&bar[XB_TOPGEN]) == tg, bar);
            __builtin_amdgcn_fence(__ATOMIC_ACQUIRE, "agent");
            xb_add(&bar[XB_XGEN(b.x)], 1u);
            asm volatile("s_waitcnt vmcnt(0)" ::: "memory");
        } else {
            XB_SPIN(xb_ld(&bar[XB_XGEN(b.x)]) == gen, bar);
            __builtin_amdgcn_fence(__ATOMIC_ACQUIRE, "agent");
            asm volatile("s_waitcnt vmcnt(0)" ::: "memory");
        }
    }
    __syncthreads();
}

__device__ __forceinline__ float wave_sum(float v) {
#pragma unroll
    for (int o = 1; o < 64; o <<= 1) v += __shfl_xor(v, o);
    return v;
}
__device__ __forceinline__ unsigned f2bf(float f) { unsigned u = __builtin_bit_cast(unsigned, f); return (u + 0x7fffu + ((u >> 16) & 1u)) >> 16; }
__device__ __forceinline__ unsigned pk2(float lo, float hi) { return f2bf(lo) | (f2bf(hi) << 16); }
__device__ __forceinline__ void conv_item(const float* W, int K, int N, const float* g, bf16_t* WT, int s_lo, int s_hi, LAS float* scr, int item, int lane) {
    const int nblk = (N + 31) / 32, kb = item / nblk, nb = item - kb * nblk, k0 = 64 * kb, n0 = 32 * nb;
    const int nl = n0 + (lane & 31);
    float v[32];
    const float* wp = W + (size_t)(k0 + (lane >> 5)) * N + nl;
#pragma unroll
    for (int i = 0; i < 32; ++i) v[i] = (nl < N) ? *(const GAS float*)(wp + (size_t)(2 * i) * N) : 0.f;
    const int c = lane & 7;
    f32x4 g0 = {1.f, 1.f, 1.f, 1.f}, g1 = {1.f, 1.f, 1.f, 1.f};
    if (g) { g0 = *(const GAS f32x4*)(g + k0 + 8 * c); g1 = *(const GAS f32x4*)(g + k0 + 8 * c + 4); }
#pragma unroll
    for (int i = 0; i < 32; ++i) scr[(2 * i + (lane >> 5)) * 33 + (lane & 31)] = v[i];
    LDS_WAIT(); asm volatile("" ::: "memory");
#pragma unroll
    for (int j = 0; j < 4; ++j) {
        const int n = (lane >> 3) + 8 * j; const LAS float* s = scr + (8 * c) * 33 + n;
        const float cs = ((n0 + n) < s_lo || (n0 + n) >= s_hi) ? 0.125f : 1.0f;
        u32x4 o; o.x = pk2(s[0 * 33] * g0[0] * cs, s[1 * 33] * g0[1] * cs); o.y = pk2(s[2 * 33] * g0[2] * cs, s[3 * 33] * g0[3] * cs);
        o.z = pk2(s[4 * 33] * g1[0] * cs, s[5 * 33] * g1[1] * cs); o.w = pk2(s[6 * 33] * g1[2] * cs, s[7 * 33] * g1[3] * cs);
        if (n0 + n < N) *(GAS u32x4*)(WT + (size_t)(n0 + n) * K + k0 + 8 * c) = o;
    }
    LDS_WAIT(); asm volatile("" ::: "memory");
}
__device__ __forceinline__ void rows2_to_bf16(const float* xrow, bf16_t* orow, float* ssrow, int lane) {
    const GAS f32x4* xr = (const GAS f32x4*)xrow + lane;
    f32x4 v[8]; float s0 = 0.f, s1 = 0.f;
#pragma unroll
    for (int j = 0; j < 8; ++j) v[j] = xr[64 * j];
#pragma unroll
    for (int j = 0; j < 4; ++j) { s0 += (v[j][0] * v[j][0] + v[j][1] * v[j][1]) + (v[j][2] * v[j][2] + v[j][3] * v[j][3]);
                                  s1 += (v[4 + j][0] * v[4 + j][0] + v[4 + j][1] * v[4 + j][1]) + (v[4 + j][2] * v[4 + j][2] + v[4 + j][3] * v[4 + j][3]); }
    GAS u32x2* o8 = (GAS u32x2*)orow + lane;
#pragma unroll
    for (int j = 0; j < 8; ++j) { u32x2 w; w.x = pk2(v[j][0], v[j][1]); w.y = pk2(v[j][2], v[j][3]); o8[64 * j] = w; }
    s0 = wave_sum(s0); s1 = wave_sum(s1);
    if (lane < 8) ssrow[lane] = (lane == 0) ? s0 : (lane == 4 ? s1 : 0.f);
}

struct Params { const float* in[15]; float* out; unsigned char* ws; };

__global__ void __launch_bounds__(NTHREADS, 2) yoco_fwd(Params P) {
    extern __shared__ __attribute__((aligned(16))) unsigned char lds_raw[];
    cg::grid_group grid = cg::this_grid();
    LAS unsigned char* lds = (LAS unsigned char*)lds_raw;
    const int G = gridDim.x, bx = blockIdx.x;
    for (int u = threadIdx.x; u < (LDS_BYTES - 131072) / 4; u += NTHREADS) ((LAS unsigned*)(lds + 131072))[u] = 0u;
    __syncthreads();
    const XcdBarrier xbar = xcd_barrier_post((unsigned*)(P.ws + WS_CTL) + CW_BAR, (volatile LAS unsigned*)(lds + MISC_OFF));
#define WSP(T, off) ((T*)(ws + (off)))
#define g_ctl WSP(unsigned, WS_CTL)
#define g_ss WSP(float, WS_SS)
#define g_cbuf WSP(float, WS_C)
#define g_ssm WSP(float, WS_SSM)
#define g_totb WSP(float, WS_TOT)
#define g_memb WSP(bf16_t, WS_MEMB)
#define g_memkv WSP(bf16_t, WS_MEMKV)
#define g_Wina WSP(bf16_t, WS_WINA)
#define g_Wcat WSP(bf16_t, WS_WCAT)
#define g_Winb1 WSP(bf16_t, WS_WINB1)
#define g_Wmem WSP(bf16_t, WS_WMEM)
#define g_Wo WSP(bf16_t, WS_WO)
#define g_W1 WSP(bf16_t, WS_W1)
#define g_W2 WSP(bf16_t, WS_W2)
#define g_hb WSP(bf16_t, WS_HB)
#define g_Ksh WSP(bf16_t, WS_KSH)
#define g_Vsh WSP(bf16_t, WS_VSH)
#define g_proj WSP(bf16_t, WS_A)
#define g_merged WSP(bf16_t, WS_MERGED)
#define g_hidden WSP(bf16_t, WS_A)
#define g_hout (P.out)

    {
        unsigned char* ws = P.ws;
        const int tid = threadIdx.x, lane = tid & 63, wave = __builtin_amdgcn_readfirstlane(tid >> 6);
        LAS float* scr = (LAS float*)(lds + wave * 16384);
        const int gw = bx * NWAVES + wave, NGW = G * NWAVES;
        for (int mi = 0; mi < 21; ++mi) {
            const float* W; const float* g = nullptr; bf16_t* WT; int K = 1024, N, s_lo = 0, s_hi = 0x7fffffff;
            if (mi < 2) { W = P.in[3] + (size_t)mi * 1024 * 1792; N = 1792; g = P.in[2] + mi * 1024; WT = g_Wina + (size_t)mi * 1792 * 1024; s_lo = 512; s_hi = 1536; }
            else if (mi == 2) { W = P.in[4]; N = 768; g = P.in[2] + 2 * 1024; WT = g_Wcat; s_lo = 768; }
            else if (mi == 3) { W = P.in[12]; N = 1032; g = P.in[11]; WT = g_Wcat + (size_t)768 * 1024; }
            else if (mi == 4) { W = P.in[4] + (size_t)1024 * 768; N = 768; g = P.in[2] + 3 * 1024; WT = g_Winb1; s_lo = 768; }
            else if (mi < 9) { const int l = mi - 5; W = P.in[5] + (size_t)l * 1024 * 512; N = 512; g = P.in[6] + l * 1024; WT = g_Wmem + (size_t)l * 512 * 1024; }
            else if (mi < 13) { const int l = mi - 9; W = P.in[7] + (size_t)l * 768 * 1024; K = 768; N = 1024; WT = g_Wo + (size_t)l * 1024 * 768; }
            else if (mi < 17) { const int l = mi - 13; W = P.in[9] + (size_t)l * 1024 * 4096; N = 4096; g = P.in[8] + l * 1024; WT = g_W1 + (size_t)l * 4096 * 1024; }
            else { const int l = mi - 17; W = P.in[10] + (size_t)l * 4096 * 1024; K = 4096; N = 1024; WT = g_W2 + (size_t)l * 1024 * 4096; }
            const int nitems = (K / 64) * ((N + 31) / 32);
            for (int it = gw; it < nitems; it += NGW) conv_item(W, K, N, g, WT, s_lo, s_hi, scr, it, lane);
        }
        { u32x4* z = (u32x4*)(g_Wcat + (size_t)1800 * 1024); const int nz = 248 * 1024 * 2 / 16; const u32x4 zero = {0u, 0u, 0u, 0u};
          for (int e = gw * 64 + lane; e < nz; e += NGW * 64) z[e] = zero; }
        for (int m = 2 * gw; m < MROWS; m += 2 * NGW) rows2_to_bf16(P.in[0] + (size_t)m * 1024, g_hb + (size_t)m * 1024, g_ss + (size_t)m * 4, lane);
        for (int m = 2 * gw; m < MEMROWS; m += 2 * NGW) rows2_to_bf16(P.in[1] + (size_t)m * 1024, g_memb + (size_t)m * 1024, g_ssm + (size_t)m * 4, lane);
    }
    if (P.ws == nullptr) grid.sync();
    xcd_barrier(xbar);

    for (int l = 0; l < 4; ++l) {
        for (int sub = 0; sub < 5; ++sub) {
            unsigned char* ws = P.ws; asm volatile("" : "+s"(ws));
            int tid = threadIdx.x; asm volatile("" : "+v"(tid)); const int lane = tid & 63;
            switch (sub) {
            case 0: case 3: {
                for (int pass = (l == 0 && sub == 0) ? 0 : 1; pass < 2; ++pass) {
                    pg8::Gemm g; pg8::EpiProj E; E.ss = g_ss; E.act = 0; E.cat = 0; E.Ksh = g_Ksh; E.Vsh = g_Vsh; E.flog = g_cbuf; int cidx = bx;
                    if (pass == 0) { g.A = g_memb; g.Bt = g_Wmem; g.M = MEMROWS; g.N = 2048; g.K = 1024; E.ss = g_ssm; E.O = g_memkv; E.ldc = MEMKV_LD; cidx = (bx + G / 2) % G; }
                    else if (sub == 3) { g.A = g_hb; g.Bt = g_W1 + (size_t)l * 4096 * 1024; g.M = MROWS; g.N = DFF; g.K = 1024; E.O = g_hidden; E.ldc = DFF; E.act = 1; }
                    else if (l < 2) { g.A = g_hb; g.Bt = g_Wina + (size_t)l * 1792 * 1024; g.M = MROWS; g.N = 1792; g.K = 1024; E.O = g_proj; E.ldc = 1792; }
                    else if (l == 2) { g.A = g_hb; g.Bt = g_Wcat; g.M = MROWS; g.N = 2048; g.K = 1024; E.O = g_proj; E.ldc = 768; E.cat = 1; }
                    else { g.A = g_hb; g.Bt = g_Winb1; g.M = MROWS; g.N = 768; g.K = 1024; E.O = g_proj; E.ldc = 768; }
                    pg8::StaticOrder S; S.init(g.M, g.N, G, cidx);
                    pg8::gemm_phase<pg8::EpiProj, pg8::StaticOrder, true, true>(lds, g, S, E);
                }
            } break;
            case 1: {
                if (l == 2) {
                    LAS float* sb = (LAS float*)lds;
                    for (int ch = bx; ch < MROWS / 128; ch += G) {
                        const int r0 = ch * 128;
                        for (int e = tid; e < 1024; e += NTHREADS) {
                            const float f = g_cbuf[(size_t)r0 * 8 + e] + P.in[13][e & 7];
                            sb[e] = -(fmaxf(-f, 0.f) + log1pf(expf(-fabsf(f))));
                        }
                        __syncthreads();
                        if (tid < 8) { float a = 0.f; for (int r = 0; r < 128; ++r) { a += sb[r * 8 + tid]; sb[r * 8 + tid] = a; } g_totb[ch * 8 + tid] = a; }
                        __syncthreads();
                        for (int e = tid; e < 1024; e += NTHREADS) g_cbuf[(size_t)r0 * 8 + e] = sb[e];
                        float mx = 0.f;
                        for (int e = tid; e < 1024; e += NTHREADS) {
                            const bf16x8* kp = (const bf16x8*)(g_Ksh + (size_t)(r0 + (e >> 3)) * 512 + (e & 7) * 64); float s = 0.f;
#pragma unroll
                            for (int c = 0; c < 8; ++c) { const bf16x8 v = kp[c];
#pragma unroll
                                for (int j = 0; j < 8; ++j) { const float f = att::bf2f(v[j]); s += f * f; } }
                            mx = fmaxf(mx, s);
                        }
                        mx = fmaxf(mx, __shfl_xor(mx, 8)); mx = fmaxf(mx, __shfl_xor(mx, 16)); mx = fmaxf(mx, __shfl_xor(mx, 32));
                        if (lane < 8) atomicMax(g_ctl + CW_KMAX + (r0 >> 14) * 8 + lane, __float_as_uint(mx));
                        __syncthreads();
                    }
                    xcd_barrier(xbar);
                    for (int ch = bx; ch < MROWS / 128; ch += G) {
                        const int r0 = ch * 128, c0 = ch & ~127;
                        {
                          const int hd8 = tid & 7, j = tid >> 3; float a = 0.f;
                          if (c0 + j < ch) a += *(const GAS float*)(g_totb + (size_t)(c0 + j) * 8 + hd8);
                          if (c0 + 64 + j < ch) a += *(const GAS float*)(g_totb + (size_t)(c0 + 64 + j) * 8 + hd8);
                          a += __shfl_xor(a, 8); a += __shfl_xor(a, 16); a += __shfl_xor(a, 32);
                          if (lane < 8) sb[16 + (tid >> 6) * 8 + lane] = a;
                          __syncthreads();
                          if (tid < 8) { float s = 0.f;
#pragma unroll
                              for (int w = 0; w < 8; ++w) s += sb[16 + w * 8 + tid];
                              sb[tid] = s; }
                        }
                        __syncthreads();
                        for (int e = tid; e < 1024; e += NTHREADS) g_cbuf[(size_t)r0 * 8 + e] += sb[e & 7];
                        __syncthreads();
                    }
                    xcd_barrier(xbar);
                }
                {
                    const int ldp = (l < 2) ? 1792 : 768;
                    const int grp = __builtin_amdgcn_readfirstlane(tid >> 8);
                    LAS unsigned char* glds = lds + grp * att::GSZ;
                    LAS unsigned* gbar = (LAS unsigned*)(lds + 131072 + 16) + grp;
                    __syncthreads();
                    unsigned gen = (unsigned)__builtin_amdgcn_readfirstlane((int)*(volatile LAS unsigned*)gbar) >> 2;
                    for (int u = 2 * bx + grp; u < 3072; u += 2 * G) {
                        if (u < 2048) {
                            const int gq = u & 511, kk = u >> 9, cb = gq >> 1, bh = (cb & 7) * 2 + (cb >> 7), qb = (((cb >> 3) & 15) * 2 + (gq & 1)) * 4 + kk, hd = bh & 7, b = bh >> 3, q0 = 128 * qb;
                            const size_t rq = (size_t)b * SEQ + q0, rk = (size_t)b * SEQ;
                            if (l < 2) att::attn_unit<0>(glds, gbar, gen, g_proj + rq * 1792 + hd * 64, 1792, g_proj + rk * 1792 + 512 + hd * 64, 1792, g_proj + rk * 1792 + 1024 + hd * 64, 1792,
                                                         g_merged + rq * 768 + hd * 64, 768, nullptr, nullptr, 0.f, q0, (q0 >> 6) + 1);
                            else { const float kmax2 = sqrtf(__uint_as_float(g_ctl[CW_KMAX + b * 8 + hd])) * att::LOG2E;
                                   att::attn_unit<1>(glds, gbar, gen, g_proj + rq * 768 + hd * 64, 768, g_Ksh + rk * 512 + hd * 64, 512, g_Vsh + rk * 512 + hd * 64, 512,
                                                     g_merged + rq * 768 + hd * 64, 768, g_cbuf + rq * 8 + hd, g_cbuf + rk * 8 + hd, kmax2, q0, (q0 >> 6) + 1); }
                        } else {
                            const int u2 = u - 2048, rb = u2 & 255, hm = u2 >> 8; const size_t rq = (size_t)rb * 128; const int b = (int)(rq >> 14);
                            const bf16_t* qp = g_proj + rq * ldp + ((l < 2) ? 1536 : 512) + hm * 64;
                            const bf16_t* kp = g_memkv + (size_t)(b * NMEM) * MEMKV_LD + l * 512 + hm * 64;
                            att::attn_unit<2>(glds, gbar, gen, qp, ldp, kp, MEMKV_LD, kp + 256, MEMKV_LD, g_merged + rq * 768 + 512 + hm * 64, 768, nullptr, nullptr, 0.f, 0, 3);
                        }
                    }
                    __syncthreads();
                }
            } break;
            default: {
                pg8::Gemm g; g.M = MROWS; g.N = 1024;
                if (sub == 2) { g.A = g_merged; g.Bt = g_Wo + (size_t)l * 1024 * 768; g.K = 768; } else { g.A = g_hidden; g.Bt = g_W2 + (size_t)l * 1024 * 4096; g.K = DFF; }
                pg8::EpiRes E; E.hb = g_hb; E.ss = g_ss; E.red = (LAS float*)(lds + 131072 + 1024);
                pg8::StaticOrder S; S.init(g.M, g.N, G, bx);
                pg8::gemm_phase<pg8::EpiRes, pg8::StaticOrder, true, true>(lds, g, S, E);
            } break;
            }
            xcd_barrier(xbar);
        }
    }
    {
        unsigned char* ws = P.ws; asm volatile("" : "+s"(ws));
        int tid_l = threadIdx.x; asm volatile("" : "+v"(tid_l));
        const int tid = tid_l, lane = tid & 63, wave = __builtin_amdgcn_readfirstlane(tid >> 6);
        const int gw = bx * NWAVES + wave, NGW = G * NWAVES;
        const f32x4* gp = (const f32x4*)P.in[14] + lane;
        f32x4 gv[4];
#pragma unroll
        for (int j = 0; j < 4; ++j) gv[j] = gp[64 * j];
        for (int m = gw; m < MROWS; m += NGW) {
            float s = (lane < 4) ? *(const GAS float*)(g_ss + (size_t)m * 4 + lane) : 0.f;
            s = wave_sum(s);
            const float rs = 1.0f / sqrtf(s * (1.0f / 1024.0f) + pg8::RMS_EPS);
            const GAS u32x2* hr = (const GAS u32x2*)(g_hb + (size_t)m * 1024) + lane;
            GAS f32x4* xr = (GAS f32x4*)(g_hout + (size_t)m * 1024) + lane;
#pragma unroll
            for (int j = 0; j < 4; ++j) { const u32x2 w = hr[64 * j]; const f32x4 v = {pg8::bf_lo(w.x), pg8::bf_hi(w.x), pg8::bf_lo(w.y), pg8::bf_hi(w.y)}; xr[64 * j] = v * rs * gv[j]; }
        }
    }
}

extern "C" void kernel_launch(void* const* d_in, const int* in_sizes, int n_in, void* d_out, int out_size, void* d_ws, size_t ws_size, hipStream_t stream) {
    static int grid = 0;
    if (grid == 0) {
        if (n_in != 15 || in_sizes[0] != MROWS * D_MODEL || out_size != MROWS * D_MODEL || ws_size < WS_END) {
            fprintf(stderr, "kernel_launch: unexpected shapes / workspace (n_in %d, in0 %d, out %d, ws %zu < %zu); nothing launched\n", n_in, n_in > 0 ? in_sizes[0] : -1, out_size, ws_size, (size_t)WS_END);
            grid = -1; return;
        }
        int dev = 0, cus = 0, per_cu = 0;
        if (hipGetDevice(&dev) != hipSuccess || hipDeviceGetAttribute(&cus, hipDeviceAttributeMultiprocessorCount, dev) != hipSuccess) { fprintf(stderr, "kernel_launch: device query failed\n"); grid = -1; return; }
        if (hipFuncSetAttribute((const void*)yoco_fwd, hipFuncAttributeMaxDynamicSharedMemorySize, LDS_BYTES) != hipSuccess) { fprintf(stderr, "kernel_launch: hipFuncSetAttribute failed\n"); grid = -1; return; }
        if (hipOccupancyMaxActiveBlocksPerMultiprocessor(&per_cu, (const void*)yoco_fwd, NTHREADS, LDS_BYTES) != hipSuccess || per_cu < 1) { fprintf(stderr, "kernel_launch: occupancy query says %d\n", per_cu); per_cu = 1; }
        (void)hipGetLastError();
        grid = cus * 1;
    }
    if (grid < 0) return;
    (void)hipMemsetAsync((char*)d_ws + WS_CTL, 0, CTL_ZERO_BYTES, stream);
    Params p{};
    for (int i = 0; i < 15; ++i) p.in[i] = (const float*)d_in[i];
    p.out = (float*)d_out; p.ws = (unsigned char*)d_ws;
    void* args[] = {&p};
    hipError_t e = hipLaunchCooperativeKernel((const void*)yoco_fwd, dim3(grid), dim3(NTHREADS), args, LDS_BYTES, stream);
    if (e != hipSuccess) fprintf(stderr, "kernel_launch: cooperative launch failed: %s (grid %d)\n", hipGetErrorString(e), grid);
}
```

```cpp
#include <hip/hip_runtime.h>
#include <hip/hip_cooperative_groups.h>
#include <cstdio>
#include <cstdint>
namespace cg = cooperative_groups;
namespace pg8 {
#define PG8_LAS __attribute__((address_space(3)))
typedef unsigned short bf16_t;
typedef short bf16x8 __attribute__((ext_vector_type(8)));
typedef float f32x4 __attribute__((ext_vector_type(4)));
typedef unsigned u32x4 __attribute__((ext_vector_type(4)));
constexpr int BM = 256, BK = 64, HALF = 128, HTB = HALF * BK * 2  , STAGE_BYTES = 8 * HTB, NXCD = 8, WGM = 8;

__host__ __device__ __forceinline__ int lds_byte(int r, int c) { const int st = (r >> 4) * 2 + (c >> 5), rr = r & 15, cc = c & 31, ob = rr * 64 + cc * 2; return st * 1024 + (ob ^ (((ob >> 9) & 1) << 5)); }
__host__ __device__ __forceinline__ void stage_rc(int b, int& R, int& C) { const int st = b / 1024, sb = b % 1024, swz = sb ^ (((sb >> 9) & 1) << 5); R = (st >> 1) * 16 + swz / 64; C = (st & 1) * 32 + (swz % 64) / 2; }
__host__ __device__ __forceinline__ int perm32(int rho) { const int n = rho >> 4, i = rho & 15; return 8 * (i >> 2) + 4 * n + (i & 3); }

struct Unit { int pm, pn; };
struct Gemm { const bf16_t* A; const bf16_t* Bt; int M, N, K; };

struct StaticOrder {
    int nM, nN, nwg, G, c;
    __host__ __device__ void init(int M, int N, int G_, int c_) { nM = M / BM; nN = N / BM; nwg = nM * nN; G = G_; c = c_; }
    __host__ __device__ bool next(int i, Unit& u) const {
        const long L = (long)i * G + c; if (L >= nwg) return false;
        int wgid = (int)L; { const int q = nwg / NXCD, r = nwg % NXCD, xcd = wgid % NXCD, off = wgid / NXCD; wgid = (xcd < r ? xcd * (q + 1) : r * (q + 1) + (xcd - r) * q) + off; }
        const int nig = WGM * nN, gid = wgid / nig, fm = gid * WGM, gsz = (nM - fm) < WGM ? (nM - fm) : WGM;
        u.pm = fm + ((wgid % nig) % gsz); u.pn = (wgid % nig) / gsz; return true;
    }
    __device__ __forceinline__ void a_ready(const Unit&) const {}
    __device__ __forceinline__ void done(const Unit&) const {}
};
__device__ __forceinline__ unsigned cvt_pk_bf16(float lo, float hi) { unsigned r; asm volatile("v_cvt_pk_bf16_f32 %0, %1, %2" : "=v"(r) : "v"(lo), "v"(hi)); return r; }
constexpr float RMS_EPS = 1e-6f;
typedef unsigned u32x2 __attribute__((ext_vector_type(2)));
#define PG8_GAS __attribute__((address_space(1)))
struct EpiProj {
    static constexpr bool PERM = true, AFTER_DRAIN = false;
    const float* ss; bf16_t* O; int ldc; int act; int cat; bf16_t* Ksh; bf16_t* Vsh; float* flog;
    __device__ __forceinline__ void operator()(const f32x4 (&acc)[2][2][4][2], const Unit& u, int wr, int wc, int fr, int fq) const {
        const int row0 = u.pm * BM + wr * 64 + fr;
        bf16_t* base = O; int ld = ldc; int colt = u.pn * BM; int kind = 0;
        if (cat) { if (u.pn >= 7) kind = 2; else if (u.pn >= 5) { base = Vsh; ld = 512; colt = (u.pn - 5) * BM; } else if (u.pn >= 3) { base = Ksh; ld = 512; colt = (u.pn - 3) * BM; } }
        const int col0 = colt + wc * 32 + 8 * fq;
        f32x4 sv[2][4];
#pragma unroll
        for (int ai = 0; ai < 2; ++ai)
#pragma unroll
            for (int m = 0; m < 4; ++m) sv[ai][m] = *(const PG8_GAS f32x4*)(ss + (size_t)(row0 + ai * HALF + m * 16) * 4);
#pragma unroll
        for (int ai = 0; ai < 2; ++ai)
#pragma unroll
            for (int m = 0; m < 4; ++m) {
                const int row = row0 + ai * HALF + m * 16;
                const f32x4 sa = sv[ai][m];
                const float t = (sa[0] + sa[1]) + (sa[2] + sa[3]);
                const float rs = __builtin_amdgcn_rsqf(t * (1.0f / 1024.0f) + RMS_EPS);
                if (kind == 2) {
                    if (wc == 0 && fq == 0) { const f32x4 v0 = acc[ai][0][m][0] * rs, v1 = acc[ai][0][m][1] * rs; *(PG8_GAS f32x4*)(flog + (size_t)row * 8) = v0; *(PG8_GAS f32x4*)(flog + (size_t)row * 8 + 4) = v1; }
                } else {
                    bf16_t* rowp = base + (size_t)row * ld + col0;
#pragma unroll
                    for (int bj = 0; bj < 2; ++bj) {
                        f32x4 v0 = acc[ai][bj][m][0] * rs, v1 = acc[ai][bj][m][1] * rs;
                        if (act) {
#pragma unroll
                            for (int j = 0; j < 4; ++j) { const float a = fmaxf(v0[j], 0.f), b = fmaxf(v1[j], 0.f); v0[j] = a * a; v1[j] = b * b; }
                        }
                        u32x4 w; w.x = cvt_pk_bf16(v0[0], v0[1]); w.y = cvt_pk_bf16(v0[2], v0[3]); w.z = cvt_pk_bf16(v1[0], v1[1]); w.w = cvt_pk_bf16(v1[2], v1[3]);
                        *(PG8_GAS u32x4*)(rowp + bj * HALF) = w;
                    }
                }
            }
    }
};
__device__ __forceinline__ float bf_lo(unsigned w) { return __uint_as_float(w << 16); }
__device__ __forceinline__ float bf_hi(unsigned w) { return __uint_as_float(w & 0xffff0000u); }
struct EpiRes {
    static constexpr bool PERM = false, AFTER_DRAIN = false;
    bf16_t* hb; float* ss; PG8_LAS float* red;
    __device__ __forceinline__ void operator()(const f32x4 (&acc)[2][2][4][2], const Unit& u, int wr, int wc, int fr, int fq) const {
        const int col0 = u.pn * BM + wc * 32 + 4 * fq;
#pragma unroll
        for (int ai = 0; ai < 2; ++ai) {
            u32x2 b[4][2][2];
#pragma unroll
            for (int m = 0; m < 4; ++m) {
                const size_t off = (size_t)(u.pm * BM + ai * HALF + wr * 64 + m * 16 + fr) * 1024 + col0;
#pragma unroll
                for (int bj = 0; bj < 2; ++bj)
#pragma unroll
                    for (int n = 0; n < 2; ++n) b[m][bj][n] = *(const PG8_GAS u32x2*)(hb + off + bj * HALF + n * 16);
            }
#pragma unroll
            for (int m = 0; m < 4; ++m) {
                const int rt = ai * HALF + wr * 64 + m * 16 + fr; const size_t off = (size_t)(u.pm * BM + rt) * 1024 + col0; float q = 0.f;
#pragma unroll
                for (int bj = 0; bj < 2; ++bj)
#pragma unroll
                    for (int n = 0; n < 2; ++n) {
                        const f32x4 a = acc[ai][bj][m][n]; const u32x2 bb = b[m][bj][n];
                        u32x2 w; w.x = cvt_pk_bf16(bf_lo(bb.x) + a[0], bf_hi(bb.x) + a[1]); w.y = cvt_pk_bf16(bf_lo(bb.y) + a[2], bf_hi(bb.y) + a[3]);
                        *(PG8_GAS u32x2*)(hb + off + bj * HALF + n * 16) = w;
                        const float o0 = bf_lo(w.x), o1 = bf_hi(w.x), o2 = bf_lo(w.y), o3 = bf_hi(w.y);
                        q += (o0 * o0 + o1 * o1) + (o2 * o2 + o3 * o3);
                    }
                q += __shfl_xor(q, 16); q += __shfl_xor(q, 32);
                if (fq == 0) red[rt * 4 + wc] = q;
            }
            asm volatile("" ::: "memory");
        }
        asm volatile("s_waitcnt lgkmcnt(0)" ::: "memory"); __builtin_amdgcn_s_barrier(); asm volatile("" ::: "memory");
        int t = threadIdx.x; asm volatile("" : "+v"(t));
        if (t < 256) { const f32x4 v = *(const PG8_LAS f32x4*)(red + t * 4); *(PG8_GAS float*)(ss + (size_t)(u.pm * BM + t) * 4 + u.pn) = (v[0] + v[1]) + (v[2] + v[3]); }
    }
};
template <class Epi, class Sched, bool ALIGN_EPI = false, bool SP2 = false>
__device__ __forceinline__ void gemm_phase(PG8_LAS unsigned char* lds, const Gemm g, const Sched& S, const Epi& E) {
    int tid_l = threadIdx.x; asm volatile("" : "+v"(tid_l));
    const int tid = tid_l, wid = __builtin_amdgcn_readfirstlane(tid >> 6), lane = tid & 63, wr = wid >> 2, wc = wid & 3, fr = lane & 15, fq = lane >> 4;
    const int K = g.K, nt = K / BK;
    unsigned voffA[2], voffB[2];
#pragma unroll
    for (int i = 0; i < 2; ++i) { int R, C; stage_rc(tid * 16 + i * 8192, R, C); const int Rb = Epi::PERM ? ((R & ~31) + perm32(R & 31)) : R;
        voffA[i] = (unsigned)(R * K + C) * 2u; voffB[i] = (unsigned)(Rb * K + C) * 2u; }
    const size_t kstep = (size_t)(BK * 2);
    const size_t hstep = (size_t)HALF * K * 2;
    const size_t tstep = 2 * hstep;
    const unsigned ldsw = (unsigned)wid * 1024u;
    const int aoff = lds_byte(wr * 64 + fr, fq * 8), boff = lds_byte(wc * 32 + fr, fq * 8);
#define PG8_SA(b, h) (((b) * 2 + (h)) * HTB)
#define PG8_SB(b, h) ((4 + (b) * 2 + (h)) * HTB)
#define PG8_STAGE(bufoff, gbase, voff) do { _Pragma("unroll") for (int _i = 0; _i < 2; ++_i) \
        __builtin_amdgcn_global_load_lds((const unsigned*)((const char*)(gbase) + (voff)[_i]), (PG8_LAS unsigned*)(lds + (bufoff) + ldsw + _i * 8192), 16, 0, 0); } while (0)
#define PG8_LDA(dst, b, h) do { _Pragma("unroll") for (int m = 0; m < 4; ++m) _Pragma("unroll") for (int k = 0; k < 2; ++k) dst[m][k] = *(const PG8_LAS bf16x8*)(lds + PG8_SA(b, h) + aoff + m * 2048 + k * 1024); } while (0)
#define PG8_LDB(dst, b, h) do { _Pragma("unroll") for (int n = 0; n < 2; ++n) _Pragma("unroll") for (int k = 0; k < 2; ++k) dst[n][k] = *(const PG8_LAS bf16x8*)(lds + PG8_SB(b, h) + boff + n * 2048 + k * 1024); } while (0)
#define PG8_MMA(ai, bj, At, Bt) do { __builtin_amdgcn_s_setprio(1); _Pragma("unroll") for (int m = 0; m < 4; ++m) _Pragma("unroll") for (int n = 0; n < 2; ++n) _Pragma("unroll") for (int k = 0; k < 2; ++k) \
        acc[ai][bj][m][n] = __builtin_amdgcn_mfma_f32_16x16x32_bf16(Bt[n][k], At[m][k], acc[ai][bj][m][n], 0, 0, 0); __builtin_amdgcn_s_setprio(0); } while (0)
#define PG8_WAIT_V(n) asm volatile("s_waitcnt vmcnt(" #n ")" ::: "memory")
#define PG8_WAIT_L(n) asm volatile("s_waitcnt lgkmcnt(" #n ")" ::: "memory")
#define PG8_BAR __builtin_amdgcn_s_barrier()
#define PG8_SCHED __builtin_amdgcn_sched_barrier(0)
    Unit cur, nxt; int ui = 0;
    if (!S.next(0, cur)) return;
    f32x4 acc[2][2][4][2];
#pragma unroll
    for (int a = 0; a < 2; ++a)
#pragma unroll
        for (int b = 0; b < 2; ++b)
#pragma unroll
            for (int m = 0; m < 4; ++m)
#pragma unroll
                for (int n = 0; n < 2; ++n) acc[a][b][m][n] = (f32x4){0.f, 0.f, 0.f, 0.f};
    bf16x8 At[4][2], B0[2][2], B1[2][2];
    const char* cA = (const char*)g.A + (size_t)cur.pm * tstep; const char* cB = (const char*)g.Bt + (size_t)cur.pn * tstep;
    S.a_ready(cur);
    if constexpr (SP2) {
        PG8_STAGE(PG8_SB(0, 0), cB, voffB); PG8_STAGE(PG8_SB(0, 1), cB + hstep, voffB); PG8_STAGE(PG8_SA(0, 0), cA, voffA); PG8_STAGE(PG8_SA(0, 1), cA + hstep, voffA);
        if (wr == 1) PG8_BAR;
        PG8_WAIT_V(2); PG8_BAR;
        PG8_STAGE(PG8_SB(1, 0), cB + kstep, voffB); PG8_STAGE(PG8_SA(1, 0), cA + kstep, voffA); PG8_STAGE(PG8_SB(1, 1), cB + hstep + kstep, voffB);
        PG8_WAIT_V(6); PG8_BAR;
    } else {
        PG8_STAGE(PG8_SB(0, 0), cB, voffB); PG8_STAGE(PG8_SA(0, 0), cA, voffA); PG8_STAGE(PG8_SB(0, 1), cB + hstep, voffB); PG8_STAGE(PG8_SA(0, 1), cA + hstep, voffA);
        if (wr == 1) PG8_BAR;
        PG8_WAIT_V(4); PG8_BAR;
        PG8_STAGE(PG8_SB(1, 0), cB + kstep, voffB); PG8_STAGE(PG8_SA(1, 0), cA + kstep, voffA); PG8_STAGE(PG8_SB(1, 1), cB + hstep + kstep, voffB);
        PG8_WAIT_V(6); PG8_BAR;
    }
    for (;;) {
        const bool has_next = S.next(ui + 1, nxt);
        const char* nA = has_next ? (const char*)g.A + (size_t)nxt.pm * tstep : cA; const char* nB = has_next ? (const char*)g.Bt + (size_t)nxt.pn * tstep : cB;
        for (int t = 0; t < nt; t += 2) {
            const bool last = (t == nt - 2);
            const char* a1 = cA + (size_t)(t + 1) * kstep;
            const char* a2 = last ? nA : cA + (size_t)(t + 2) * kstep; const char* b2 = last ? nB : cB + (size_t)(t + 2) * kstep;
            const char* a3 = a2 + kstep; const char* b3 = b2 + kstep;
            if (last && has_next) S.a_ready(nxt);
            if constexpr (SP2) {
            PG8_LDB(B0, 0, 0); PG8_LDB(B1, 0, 1); PG8_SCHED; PG8_LDA(At, 0, 0); PG8_STAGE(PG8_SA(1, 1), a1 + hstep, voffA);
            PG8_WAIT_V(8); PG8_WAIT_L(0); PG8_BAR; PG8_MMA(0, 0, At, B0); PG8_MMA(0, 1, At, B1); PG8_BAR; PG8_SCHED;
            PG8_LDA(At, 0, 1); PG8_STAGE(PG8_SB(0, 0), b2, voffB); PG8_STAGE(PG8_SB(0, 1), b2 + hstep, voffB); PG8_STAGE(PG8_SA(0, 0), a2, voffA);
            PG8_WAIT_V(8); PG8_WAIT_L(0); PG8_BAR; PG8_MMA(1, 0, At, B0); PG8_MMA(1, 1, At, B1); PG8_BAR; PG8_SCHED;
            PG8_LDB(B0, 1, 0); PG8_LDB(B1, 1, 1); PG8_SCHED; PG8_LDA(At, 1, 0); PG8_STAGE(PG8_SA(0, 1), a2 + hstep, voffA);
            PG8_WAIT_V(8); PG8_WAIT_L(0); PG8_BAR; PG8_MMA(0, 0, At, B0); PG8_MMA(0, 1, At, B1); PG8_BAR; PG8_SCHED;
            PG8_LDA(At, 1, 1); PG8_STAGE(PG8_SB(1, 0), b3, voffB); PG8_STAGE(PG8_SB(1, 1), b3 + hstep, voffB); PG8_STAGE(PG8_SA(1, 0), a3, voffA);
            PG8_WAIT_V(8); PG8_WAIT_L(0); PG8_BAR; PG8_MMA(1, 0, At, B0); PG8_MMA(1, 1, At, B1); PG8_BAR; PG8_SCHED;
            } else {
            PG8_LDB(B0, 0, 0); PG8_SCHED; PG8_LDA(At, 0, 0); PG8_STAGE(PG8_SA(1, 1), a1 + hstep, voffA);
            PG8_WAIT_L(8); PG8_BAR; PG8_WAIT_L(0); PG8_MMA(0, 0, At, B0); PG8_BAR; PG8_SCHED;
            PG8_LDB(B1, 0, 1); PG8_STAGE(PG8_SB(0, 0), b2, voffB);
            PG8_BAR; PG8_WAIT_L(0); PG8_MMA(0, 1, At, B1); PG8_BAR;
            PG8_LDA(At, 0, 1); PG8_STAGE(PG8_SA(0, 0), a2, voffA);
            PG8_BAR; PG8_WAIT_L(0); PG8_MMA(1, 0, At, B0); PG8_BAR; PG8_SCHED;
            PG8_STAGE(PG8_SB(0, 1), b2 + hstep, voffB);
            PG8_WAIT_V(6); PG8_BAR; PG8_MMA(1, 1, At, B1); PG8_BAR;
            PG8_LDB(B0, 1, 0); PG8_SCHED; PG8_LDA(At, 1, 0); PG8_STAGE(PG8_SA(0, 1), a2 + hstep, voffA);
            PG8_WAIT_L(8); PG8_BAR; PG8_WAIT_L(0); PG8_MMA(0, 0, At, B0); PG8_BAR; PG8_SCHED;
            PG8_LDB(B1, 1, 1); PG8_STAGE(PG8_SB(1, 0), b3, voffB);
            PG8_BAR; PG8_WAIT_L(0); PG8_MMA(0, 1, At, B1); PG8_BAR;
            PG8_LDA(At, 1, 1); PG8_STAGE(PG8_SA(1, 0), a3, voffA);
            PG8_BAR; PG8_WAIT_L(0); PG8_MMA(1, 0, At, B0); PG8_BAR; PG8_SCHED;
            PG8_STAGE(PG8_SB(1, 1), b3 + hstep, voffB);
            PG8_WAIT_V(6); PG8_BAR; PG8_MMA(1, 1, At, B1); PG8_BAR;
            }
        }
        if constexpr (ALIGN_EPI) { if (wr == 0) PG8_BAR; }
        if constexpr (!Epi::AFTER_DRAIN) { E(acc, cur, wr, wc, fr, fq); S.done(cur); }
        if (!has_next) break;
#pragma unroll
        for (int a = 0; a < 2; ++a)
#pragma unroll
            for (int b = 0; b < 2; ++b)
#pragma unroll
                for (int m = 0; m < 4; ++m)
#pragma unroll
                    for (int n = 0; n < 2; ++n) acc[a][b][m][n] = (f32x4){0.f, 0.f, 0.f, 0.f};
        cur = nxt; cA = nA; cB = nB; ++ui;
        if constexpr (ALIGN_EPI) { if (wr == 1) PG8_BAR; }
    }
    PG8_WAIT_V(0);
    if constexpr (!ALIGN_EPI) { if (wr == 0) PG8_BAR; }
    PG8_BAR;
    if constexpr (Epi::AFTER_DRAIN) { E.fused(acc, cur, wr, wc, fr, fq, lds, wid, lane); S.done(cur); }
#undef PG8_SA
#undef PG8_SB
#undef PG8_STAGE
#undef PG8_LDA
#undef PG8_LDB
#undef PG8_MMA
#undef PG8_WAIT_V
#undef PG8_WAIT_L
#undef PG8_BAR
#undef PG8_SCHED
}
}
constexpr int D_MODEL = 1024, NBATCH = 2, SEQ = 16384, MROWS = NBATCH * SEQ, DFF = 4096, NMEM = 256, MEMROWS = NBATCH * NMEM;
constexpr int NTHREADS = 512, NWAVES = 8;
#define LAS __attribute__((address_space(3)))
#define GAS __attribute__((address_space(1)))
typedef pg8::bf16_t bf16_t;
typedef pg8::bf16x8 bf16x8;
typedef float f32x4 __attribute__((ext_vector_type(4)));
typedef float f32x16 __attribute__((ext_vector_type(16)));
typedef unsigned u32x4 __attribute__((ext_vector_type(4)));
typedef unsigned u32x2 __attribute__((ext_vector_type(2)));
typedef short s16x4 __attribute__((ext_vector_type(4)));
typedef float f32x2_t __attribute__((ext_vector_type(2)));
typedef __bf16 bf16x2_t __attribute__((ext_vector_type(2)));
#define LDS_WAIT() asm volatile("s_waitcnt lgkmcnt(0)" ::: "memory")

constexpr size_t MiB = 1u << 20;
constexpr size_t WS_CTL = 0, CTL_ZERO_BYTES = 65536;
constexpr size_t WS_SS = 1 * MiB;
constexpr size_t WS_C = 3 * MiB;
constexpr size_t WS_MEMB = 4 * MiB;
constexpr size_t WS_MEMKV = 480 * MiB;
constexpr int MEMKV_LD = 2112;
constexpr size_t WS_SSM = 7 * MiB;
constexpr size_t WS_TOT = 7 * MiB + 65536;
constexpr size_t WS_WINA = 8 * MiB;
constexpr size_t WS_WCAT = 15 * MiB;
constexpr size_t WS_WINB1 = 19 * MiB;
constexpr size_t WS_WMEM = 21 * MiB;
constexpr size_t WS_WO = 25 * MiB;
constexpr size_t WS_W1 = 31 * MiB;
constexpr size_t WS_W2 = 63 * MiB;
constexpr size_t WS_HB = 96 * MiB;
constexpr size_t WS_KSH = 160 * MiB, WS_VSH = 192 * MiB;
constexpr size_t WS_A = 224 * MiB;
constexpr size_t WS_MERGED = WS_A + 112 * MiB;
constexpr size_t WS_END = 484 * MiB;
constexpr int CW_KMAX = 16;
constexpr int CW_BAR = 4096;
constexpr int LDS_BYTES = 147456, MISC_OFF = 131072 + 320;

namespace att {
constexpr int KP = 144, VP = 192, KBUF = 64 * KP, VBUF = 64 * VP, CBUF = 320, BUFSZ = KBUF + VBUF + CBUF, FLAG_OFF = 2 * BUFSZ;
constexpr float LOG2E = 1.4426950408889634f;
__device__ __forceinline__ unsigned cvtpk(float lo, float hi) { f32x2_t v = {lo, hi}; bf16x2_t b = __builtin_convertvector(v, bf16x2_t); return __builtin_bit_cast(unsigned, b); }
__device__ __forceinline__ float bf2f(short s) { return __uint_as_float(((unsigned)(unsigned short)s) << 16); }
typedef short v4i16_t __attribute__((ext_vector_type(4)));
__device__ __forceinline__ s16x4 vtr(const LAS unsigned char* p) { return __builtin_bit_cast(s16x4, __builtin_amdgcn_ds_read_tr16_b64_v4i16((LAS v4i16_t*)p)); }

template <int MODE, bool MASKED>
__device__ __forceinline__ void attn_tile(const LAS unsigned char* B, const bf16x8 (&qf)[4], f32x16& o0, f32x16& o1, float& R, float& mrun, float& lrun, bool& wdone,
                                          int s0, int tw, int trow, int hi, unsigned kro, unsigned vro, float qkb, float ct2) {
    f32x16 p0 = {0}, p1 = {0};
#pragma unroll
    for (int c = 0; c < 4; ++c) {
        const bf16x8 a0 = *(const LAS bf16x8*)(B + kro + c * 32);
        const bf16x8 a1 = *(const LAS bf16x8*)(B + kro + 32 * KP + c * 32);
        p0 = __builtin_amdgcn_mfma_f32_32x32x16_bf16(a0, qf[c], p0, 0, 0, 0);
        p1 = __builtin_amdgcn_mfma_f32_32x32x16_bf16(a1, qf[c], p1, 0, 0, 0);
    }
    s16x4 vf0[8], vf1[8];
#pragma unroll
    for (int kd = 0; kd < 8; ++kd) { vf0[kd] = vtr(B + vro + (16 * (kd >> 1)) * VP + 64 * (kd & 1)); vf1[kd] = vtr(B + vro + (16 * (kd >> 1) + 4) * VP + 64 * (kd & 1)); }
    float x[32];
    constexpr bool masked = MASKED;
    const int kb0 = s0 + 8 * hi;
    if (MODE == 0) {
        float om[32];
#pragma unroll
        for (int e = 0; e < 32; ++e) {
            const float ex = __builtin_amdgcn_exp2f((e < 16 ? p0[e & 15] : p1[e & 15]) * LOG2E);
            om[e] = __builtin_amdgcn_rcpf(1.0f + ex);
        }
        if (masked) {
#pragma unroll
            for (int e = 0; e < 32; ++e) if (kb0 + 16 * (e >> 3) + (e & 7) >= trow) om[e] = 1.0f;
        }
#pragma unroll
        for (int e = 0; e < 32; ++e) x[e] = 1.0f - om[e];
        float tot[4], pt[4], off[4];
#pragma unroll
        for (int k = 0; k < 4; ++k) tot[k] = ((om[8 * k] * om[8 * k + 1]) * (om[8 * k + 2] * om[8 * k + 3])) * ((om[8 * k + 4] * om[8 * k + 5]) * (om[8 * k + 6] * om[8 * k + 7]));
#pragma unroll
        for (int k = 0; k < 4; ++k) pt[k] = __shfl_xor(tot[k], 32);
        float suf = R;
#pragma unroll
        for (int k = 3; k >= 0; --k) { off[k] = hi ? suf : suf * pt[k]; suf *= tot[k] * pt[k]; }
        R = suf;
#pragma unroll
        for (int k = 0; k < 4; ++k) {
            float r = off[k];
#pragma unroll
            for (int j = 7; j >= 0; --j) { x[8 * k + j] *= r; r *= om[8 * k + j]; }
        }
        wdone = __all(R < 1e-12f) != 0;
    } else {
        if (MODE == 1) {
#pragma unroll
            for (int k = 0; k < 4; ++k) {
                const LAS f32x4* cp4 = (const LAS f32x4*)(B + KBUF + VBUF + (16 * k + 8 * hi) * 4);
                const f32x4 ca = cp4[0], cb = cp4[1];
#pragma unroll
                for (int j = 0; j < 8; ++j) { const int e = 8 * k + j; x[e] = __builtin_fmaf((e < 16 ? p0[e & 15] : p1[e & 15]), LOG2E, (j < 4 ? ca[j & 3] : cb[j & 3])); }
            }
            if (masked) {
#pragma unroll
                for (int e = 0; e < 32; ++e) if (kb0 + 16 * (e >> 3) + (e & 7) > trow) x[e] = -1e30f;
            }
        } else {
#pragma unroll
            for (int e = 0; e < 32; ++e) x[e] = (e < 16 ? p0[e & 15] : p1[e & 15]);
        }
        float mx = x[0];
#pragma unroll
        for (int e = 1; e < 32; ++e) mx = fmaxf(mx, x[e]);
        mx = fmaxf(mx, __shfl_xor(mx, 32));
        if (MODE == 2) mx *= LOG2E;
        float off = 0.f;
        if (MODE == 1) { off = ct2 - *(const LAS float*)(B + KBUF + VBUF + 256); mx += off; }
        const float mnew = fmaxf(mrun, mx), sc = __builtin_amdgcn_exp2f(mrun - mnew), sh = mnew - off;
        mrun = mnew;
        float rs = 0.f;
#pragma unroll
        for (int e = 0; e < 32; ++e) { x[e] = __builtin_amdgcn_exp2f(MODE == 2 ? __builtin_fmaf(x[e], LOG2E, -mnew) : x[e] - sh); rs += x[e]; }
        rs += __shfl_xor(rs, 32);
        lrun = lrun * sc + rs;
#pragma unroll
        for (int r = 0; r < 16; ++r) { o0[r] *= sc; o1[r] *= sc; }
        if (MODE == 1) {
            wdone = __all((qkb + off - mrun) < -50.f) != 0;
        }
    }
#pragma unroll
    for (int k = 0; k < 4; ++k) {
        u32x4 pw; pw.x = cvtpk(x[8 * k], x[8 * k + 1]); pw.y = cvtpk(x[8 * k + 2], x[8 * k + 3]); pw.z = cvtpk(x[8 * k + 4], x[8 * k + 5]); pw.w = cvtpk(x[8 * k + 6], x[8 * k + 7]);
        const bf16x8 pf = __builtin_bit_cast(bf16x8, pw);
#pragma unroll
        for (int db = 0; db < 2; ++db) {
            const s16x4 lo = vf0[2 * k + db], h4 = vf1[2 * k + db];
            const bf16x8 vf = {lo[0], lo[1], lo[2], lo[3], h4[0], h4[1], h4[2], h4[3]};
            if (db == 0) o0 = __builtin_amdgcn_mfma_f32_32x32x16_bf16(vf, pf, o0, 0, 0, 0);
            else o1 = __builtin_amdgcn_mfma_f32_32x32x16_bf16(vf, pf, o1, 0, 0, 0);
        }
    }
}

#define ATT_GROUP_BAR() do { asm volatile("s_waitcnt lgkmcnt(0)" ::: "memory"); ++gen; \
        if (lane == 0) (void)__hip_atomic_fetch_add(gbar, 1u, __ATOMIC_RELAXED, __HIP_MEMORY_SCOPE_WORKGROUP); \
        while ((unsigned)__builtin_amdgcn_readfirstlane((int)*(volatile LAS unsigned*)gbar) < 4u * gen) __builtin_amdgcn_s_sleep(1); \
        asm volatile("" ::: "memory"); } while (0)
constexpr int GSZ = 45056;
template <int MODE>
__device__ __forceinline__ void attn_unit(LAS unsigned char* lds, LAS unsigned* gbar, unsigned& gen, const bf16_t* Qp, int ldq, const bf16_t* Kp, int ldk, const bf16_t* Vp, int ldv, bf16_t* Op, int ldo,
                                          const float* cq, const float* ck, float kmax2, int q0, int itile0) {
    int tid_l = threadIdx.x; asm volatile("" : "+v"(tid_l));
    const int tid = tid_l & 255, lane = tid & 63, wid = __builtin_amdgcn_readfirstlane(tid >> 6), r32 = lane & 31, hi = lane >> 5;
    const int tw = q0 + 32 * wid, trow = tw + r32;
    bf16x8 qf[4];
    { const bf16_t* qrow = Qp + (size_t)(32 * wid + r32) * ldq + 8 * hi;
#pragma unroll
      for (int c = 0; c < 4; ++c) qf[c] = *(const GAS bf16x8*)(qrow + 16 * c); }
    float qkb = 0.f, ct2 = 0.f;
    if (MODE == 1) {
        float s = 0.f;
#pragma unroll
        for (int c = 0; c < 4; ++c)
#pragma unroll
            for (int j = 0; j < 8; ++j) { const float v = bf2f(qf[c][j]); s += v * v; }
        s += __shfl_xor(s, 32);
        qkb = sqrtf(s) * kmax2 * 1.001f + 1e-3f;
        ct2 = *(const GAS float*)(cq + (size_t)(32 * wid + r32) * 8) * LOG2E;
    }
    const int srow = tid >> 3, sch = tid & 7;
    const bf16_t* kg = Kp + (size_t)srow * ldk + sch * 8; const bf16_t* vg = Vp + (size_t)srow * ldv + sch * 8;
    const unsigned kwo = srow * KP + sch * 16, vwo = KBUF + srow * VP + sch * 16;
    u32x4 kr0, kr1, vr0, vr1; float cr = 0.f, c0r = 0.f;
#define ATT_LOAD(i) do { kr0 = *(const GAS u32x4*)(kg + (size_t)(i) * 64 * ldk); kr1 = *(const GAS u32x4*)(kg + (size_t)((i) * 64 + 32) * ldk); \
        vr0 = *(const GAS u32x4*)(vg + (size_t)(i) * 64 * ldv); vr1 = *(const GAS u32x4*)(vg + (size_t)((i) * 64 + 32) * ldv); \
        if (MODE == 1) { cr = *(const GAS float*)(ck + (size_t)((i) * 64 + (tid & 63)) * 8); c0r = *(const GAS float*)(ck + (size_t)((i) * 64) * 8); } } while (0)
#define ATT_STORE(b) do { *(LAS u32x4*)(lds + (b) * BUFSZ + kwo) = kr0; *(LAS u32x4*)(lds + (b) * BUFSZ + kwo + 32 * KP) = kr1; \
        *(LAS u32x4*)(lds + (b) * BUFSZ + vwo) = vr0; *(LAS u32x4*)(lds + (b) * BUFSZ + vwo + 32 * VP) = vr1; \
        if (MODE == 1 && tid < 64) { *(LAS float*)(lds + (b) * BUFSZ + KBUF + VBUF + tid * 4) = (c0r - cr) * LOG2E; if (tid == 0) *(LAS float*)(lds + (b) * BUFSZ + KBUF + VBUF + 256) = c0r * LOG2E; } } while (0)
    f32x16 o0 = {0}, o1 = {0};
    float R = 1.f, mrun = -1e30f, lrun = 0.f;
    bool wdone = false;
    const int krow = (r32 & 0x13) | ((r32 & 4) << 1) | ((r32 & 8) >> 1);
    const unsigned kro = krow * KP + hi * 16;
    const unsigned vro = KBUF + (8 * hi + ((lane & 15) >> 2)) * VP + (16 * ((lane >> 4) & 1) + 4 * (lane & 3)) * 2;
    int i = itile0, cur = 0;
    ATT_LOAD(i); ATT_STORE(0);
    ATT_GROUP_BAR();
    for (;;) {
        ATT_LOAD((i > 0 ? i - 1 : 0));
        if (!wdone && (MODE == 2 || 64 * i <= tw)) {
            if (MODE != 2 && 64 * i + 64 > tw) attn_tile<MODE, true>(lds + cur * BUFSZ, qf, o0, o1, R, mrun, lrun, wdone, 64 * i, tw, trow, hi, kro, vro, qkb, ct2);
            else attn_tile<MODE, false>(lds + cur * BUFSZ, qf, o0, o1, R, mrun, lrun, wdone, 64 * i, tw, trow, hi, kro, vro, qkb, ct2);
        }
        if (i > 0) ATT_STORE(cur ^ 1);
        if (lane == 0) *(volatile LAS unsigned*)(lds + FLAG_OFF + (cur * 4 + wid) * 4) = wdone ? 0u : 1u;
        ATT_GROUP_BAR();
        if (i == 0) break;
        { const u32x4 fa = *(const LAS u32x4*)(lds + FLAG_OFF + cur * 16); if (((fa.x | fa.y) | (fa.z | fa.w)) == 0u) break; }
        --i; cur ^= 1;
    }
#undef ATT_LOAD
#undef ATT_STORE
    float inv = 1.f;
    if (MODE != 0) inv = 1.0f / lrun;
    bf16_t* orow = Op + (size_t)(32 * wid + r32) * ldo + 4 * hi;
#pragma unroll
    for (int g = 0; g < 4; ++g) {
        u32x2 w0; w0.x = cvtpk(o0[4 * g] * inv, o0[4 * g + 1] * inv); w0.y = cvtpk(o0[4 * g + 2] * inv, o0[4 * g + 3] * inv);
        u32x2 w1; w1.x = cvtpk(o1[4 * g] * inv, o1[4 * g + 1] * inv); w1.y = cvtpk(o1[4 * g + 2] * inv, o1[4 * g + 3] * inv);
        *(GAS u32x2*)(orow + 8 * g) = w0; *(GAS u32x2*)(orow + 32 + 8 * g) = w1;
    }
}
}

#define RLX_AGENT __ATOMIC_RELAXED, __HIP_MEMORY_SCOPE_AGENT
#define XB_TMO      128
#define XB_XCNT(j)  (256  + 64 * (j))
#define XB_XSUB(j)  (1280 + 64 * (j))
#define XB_XGEN(j)  (2304 + 64 * (j))
#define XB_TOP      3328
#define XB_TOPGEN   3392
#define XCD_BAR_WORDS 3456
#define XB_SPIN_CAP (1u << 18)

__device__ __forceinline__ unsigned xb_ld(unsigned* p)              { return __hip_atomic_load(p, __ATOMIC_RELAXED, __HIP_MEMORY_SCOPE_AGENT); }
__device__ __forceinline__ unsigned xb_add(unsigned* p, unsigned v) { return __hip_atomic_fetch_add(p, v, __ATOMIC_RELAXED, __HIP_MEMORY_SCOPE_AGENT); }
__device__ __forceinline__ unsigned xb_xcc_id() { return (unsigned)__builtin_amdgcn_s_getreg((3 << 11) | 20) & 0xFu; }
#define XB_SPIN(cond, bar) do { unsigned _sp = 0; while (cond) { __builtin_amdgcn_s_sleep(1); \
    if ((++_sp & 255u) == 0u) { if (xb_ld(&(bar)[XB_TMO])) break; if (_sp > XB_SPIN_CAP) { atomicAdd(&(bar)[XB_TMO], 1u); break; } } } } while (0)

struct XcdBarrier {
    unsigned* bar; unsigned x;
    volatile LAS unsigned* st;
};

__device__ __forceinline__ XcdBarrier xcd_barrier_post(unsigned* bar, volatile LAS unsigned* st) {
    XcdBarrier b; b.bar = bar; b.x = xb_xcc_id(); b.st = st;
    if (threadIdx.x == 0) (void)xb_add(&bar[XB_XCNT(b.x)], 1u);
    return b;
}
__device__ __forceinline__ void xcd_barrier_complete(unsigned* bar, unsigned x, unsigned& nloc, unsigned& nx) {
    const unsigned G = gridDim.x * gridDim.y * gridDim.z;
    unsigned sum, cnt, mine, sp = 0u;
    for (;;) {
        sum = 0u; cnt = 0u; mine = 0u;
#pragma unroll
        for (unsigned j = 0; j < 16; ++j) { const unsigned c = xb_ld(&bar[XB_XCNT(j)]); sum += c; cnt += (c > 0u) ? 1u : 0u; mine = (j == x) ? c : mine; }
        if (sum == G) break;
        __builtin_amdgcn_s_sleep(1);
        if ((++sp & 255u) == 0u) { if (xb_ld(&bar[XB_TMO])) break; if (sp > XB_SPIN_CAP) { atomicAdd(&bar[XB_TMO], 1u); break; } }
    }
    nloc = mine > 0u ? mine : 1u; nx = cnt > 0u ? cnt : 1u;
}

__device__ __forceinline__ void xcd_barrier(const XcdBarrier& b_in) {
    XcdBarrier b = b_in; asm volatile("" : "+s"(b.bar), "+s"(b.x));
    asm volatile("s_waitcnt vmcnt(0)" ::: "memory");
    __syncthreads();
    if (threadIdx.x == 0) {
        unsigned* bar = b.bar;
        __builtin_amdgcn_s_waitcnt(0);
        unsigned nloc = b.st[0], nx = b.st[1];
        if (nloc == 0u) { xcd_barrier_complete(bar, b.x, nloc, nx); b.st[0] = nloc; b.st[1] = nx; }
        const unsigned old = xb_add(&bar[XB_XSUB(b.x)], 1u);
        const unsigned gen = old / nloc;
        if (old + 1u == (gen + 1u) * nloc) {
            __builtin_amdgcn_fence(__ATOMIC_RELEASE, "agent");
            asm volatile("s_waitcnt vmcnt(0)" ::: "memory");
            const unsigned og = xb_add(&bar[XB_TOP], 1u);
            const unsigned tg = og / nx;
            if (og + 1u == (tg + 1u) * nx) xb_add(&bar[XB_TOPGEN], 1u);
            else XB_SPIN(xb_ld(&bar[XB_TOPGEN]) == tg, bar);
            __builtin_amdgcn_fence(__ATOMIC_ACQUIRE, "agent");
            xb_add(&bar[XB_XGEN(b.x)], 1u);
            asm volatile("s_waitcnt vmcnt(0)" ::: "memory");
        } else {
            XB_SPIN(xb_ld(&bar[XB_XGEN(b.x)]) == gen, bar);
            __builtin_amdgcn_fence(__ATOMIC_ACQUIRE, "agent");
            asm volatile("s_waitcnt vmcnt(0)" ::: "memory");
        }
    }
    __syncthreads();
}

__device__ __forceinline__ float wave_sum(float v) {
#pragma unroll
    for (int o = 1; o < 64; o <<= 1) v += __shfl_xor(v, o);
    return v;
}
__device__ __forceinline__ unsigned f2bf(float f) { unsigned u = __builtin_bit_cast(unsigned, f); return (u + 0x7fffu + ((u >> 16) & 1u)) >> 16; }
__device__ __forceinline__ unsigned pk2(float lo, float hi) { return f2bf(lo) | (f2bf(hi) << 16); }
__device__ __forceinline__ void conv_item(const float* W, int K, int N, const float* g, bf16_t* WT, int s_lo, int s_hi, LAS float* scr, int item, int lane) {
    const int nblk = (N + 31) / 32, kb = item / nblk, nb = item - kb * nblk, k0 = 64 * kb, n0 = 32 * nb;
    const int nl = n0 + (lane & 31);
    float v[32];
    const float* wp = W + (size_t)(k0 + (lane >> 5)) * N + nl;
#pragma unroll
    for (int i = 0; i < 32; ++i) v[i] = (nl < N) ? *(const GAS float*)(wp + (size_t)(2 * i) * N) : 0.f;
    const int c = lane & 7;
    f32x4 g0 = {1.f, 1.f, 1.f, 1.f}, g1 = {1.f, 1.f, 1.f, 1.f};
    if (g) { g0 = *(const GAS f32x4*)(g + k0 + 8 * c); g1 = *(const GAS f32x4*)(g + k0 + 8 * c + 4); }
#pragma unroll
    for (int i = 0; i < 32; ++i) scr[(2 * i + (lane >> 5)) * 33 + (lane & 31)] = v[i];
    LDS_WAIT(); asm volatile("" ::: "memory");
#pragma unroll
    for (int j = 0; j < 4; ++j) {
        const int n = (lane >> 3) + 8 * j; const LAS float* s = scr + (8 * c) * 33 + n;
        const float cs = ((n0 + n) < s_lo || (n0 + n) >= s_hi) ? 0.125f : 1.0f;
        u32x4 o; o.x = pk2(s[0 * 33] * g0[0] * cs, s[1 * 33] * g0[1] * cs); o.y = pk2(s[2 * 33] * g0[2] * cs, s[3 * 33] * g0[3] * cs);
        o.z = pk2(s[4 * 33] * g1[0] * cs, s[5 * 33] * g1[1] * cs); o.w = pk2(s[6 * 33] * g1[2] * cs, s[7 * 33] * g1[3] * cs);
        if (n0 + n < N) *(GAS u32x4*)(WT + (size_t)(n0 + n) * K + k0 + 8 * c) = o;
    }
    LDS_WAIT(); asm volatile("" ::: "memory");
}
__device__ __forceinline__ void rows2_to_bf16(const float* xrow, bf16_t* orow, float* ssrow, int lane) {
    const GAS f32x4* xr = (const GAS f32x4*)xrow + lane;
    f32x4 v[8]; float s0 = 0.f, s1 = 0.f;
#pragma unroll
    for (int j = 0; j < 8; ++j) v[j] = xr[64 * j];
#pragma unroll
    for (int j = 0; j < 4; ++j) { s0 += (v[j][0] * v[j][0] + v[j][1] * v[j][1]) + (v[j][2] * v[j][2] + v[j][3] * v[j][3]);
                                  s1 += (v[4 + j][0] * v[4 + j][0] + v[4 + j][1] * v[4 + j][1]) + (v[4 + j][2] * v[4 + j][2] + v[4 + j][3] * v[4 + j][3]); }
    GAS u32x2* o8 = (GAS u32x2*)orow + lane;
#pragma unroll
    for (int j = 0; j < 8; ++j) { u32x2 w; w.x = pk2(v[j][0], v[j][1]); w.y = pk2(v[j][2], v[j][3]); o8[64 * j] = w; }
    s0 = wave_sum(s0); s1 = wave_sum(s1);
    if (lane < 8) ssrow[lane] = (lane == 0) ? s0 : (lane == 4 ? s1 : 0.f);
}

struct Params { const float* in[15]; float* out; unsigned char* ws; };

__global__ void __launch_bounds__(NTHREADS, 2) yoco_fwd(Params P) {
    extern __shared__ __attribute__((aligned(16))) unsigned char lds_raw[];
    cg::grid_group grid = cg::this_grid();
    LAS unsigned char* lds = (LAS unsigned char*)lds_raw;
    const int G = gridDim.x, bx = blockIdx.x;
    for (int u = threadIdx.x; u < (LDS_BYTES - 131072) / 4; u += NTHREADS) ((LAS unsigned*)(lds + 131072))[u] = 0u;
    __syncthreads();
    const XcdBarrier xbar = xcd_barrier_post((unsigned*)(P.ws + WS_CTL) + CW_BAR, (volatile LAS unsigned*)(lds + MISC_OFF));
#define WSP(T, off) ((T*)(ws + (off)))
#define g_ctl WSP(unsigned, WS_CTL)
#define g_ss WSP(float, WS_SS)
#define g_cbuf WSP(float, WS_C)
#define g_ssm WSP(float, WS_SSM)
#define g_totb WSP(float, WS_TOT)
#define g_memb WSP(bf16_t, WS_MEMB)
#define g_memkv WSP(bf16_t, WS_MEMKV)
#define g_Wina WSP(bf16_t, WS_WINA)
#define g_Wcat WSP(bf16_t, WS_WCAT)
#define g_Winb1 WSP(bf16_t, WS_WINB1)
#define g_Wmem WSP(bf16_t, WS_WMEM)
#define g_Wo WSP(bf16_t, WS_WO)
#define g_W1 WSP(bf16_t, WS_W1)
#define g_W2 WSP(bf16_t, WS_W2)
#define g_hb WSP(bf16_t, WS_HB)
#define g_Ksh WSP(bf16_t, WS_KSH)
#define g_Vsh WSP(bf16_t, WS_VSH)
#define g_proj WSP(bf16_t, WS_A)
#define g_merged WSP(bf16_t, WS_MERGED)
#define g_hidden WSP(bf16_t, WS_A)
#define g_hout (P.out)

    {
        unsigned char* ws = P.ws;
        const int tid = threadIdx.x, lane = tid & 63, wave = __builtin_amdgcn_readfirstlane(tid >> 6);
        LAS float* scr = (LAS float*)(lds + wave * 16384);
        const int gw = bx * NWAVES + wave, NGW = G * NWAVES;
        for (int mi = 0; mi < 21; ++mi) {
            const float* W; const float* g = nullptr; bf16_t* WT; int K = 1024, N, s_lo = 0, s_hi = 0x7fffffff;
            if (mi < 2) { W = P.in[3] + (size_t)mi * 1024 * 1792; N = 1792; g = P.in[2] + mi * 1024; WT = g_Wina + (size_t)mi * 1792 * 1024; s_lo = 512; s_hi = 1536; }
            else if (mi == 2) { W = P.in[4]; N = 768; g = P.in[2] + 2 * 1024; WT = g_Wcat; s_lo = 768; }
            else if (mi == 3) { W = P.in[12]; N = 1032; g = P.in[11]; WT = g_Wcat + (size_t)768 * 1024; }
            else if (mi == 4) { W = P.in[4] + (size_t)1024 * 768; N = 768; g = P.in[2] + 3 * 1024; WT = g_Winb1; s_lo = 768; }
            else if (mi < 9) { const int l = mi - 5; W = P.in[5] + (size_t)l * 1024 * 512; N = 512; g = P.in[6] + l * 1024; WT = g_Wmem + (size_t)l * 512 * 1024; }
            else if (mi < 13) { const int l = mi - 9; W = P.in[7] + (size_t)l * 768 * 1024; K = 768; N = 1024; WT = g_Wo + (size_t)l * 1024 * 768; }
            else if (mi < 17) { const int l = mi - 13; W = P.in[9] + (size_t)l * 1024 * 4096; N = 4096; g = P.in[8] + l * 1024; WT = g_W1 + (size_t)l * 4096 * 1024; }
            else { const int l = mi - 17; W = P.in[10] + (size_t)l * 4096 * 1024; K = 4096; N = 1024; WT = g_W2 + (size_t)l * 1024 * 4096; }
            const int nitems = (K / 64) * ((N + 31) / 32);
            for (int it = gw; it < nitems; it += NGW) conv_item(W, K, N, g, WT, s_lo, s_hi, scr, it, lane);
        }
        { u32x4* z = (u32x4*)(g_Wcat + (size_t)1800 * 1024); const int nz = 248 * 1024 * 2 / 16; const u32x4 zero = {0u, 0u, 0u, 0u};
          for (int e = gw * 64 + lane; e < nz; e += NGW * 64) z[e] = zero; }
        for (int m = 2 * gw; m < MROWS; m += 2 * NGW) rows2_to_bf16(P.in[0] + (size_t)m * 1024, g_hb + (size_t)m * 1024, g_ss + (size_t)m * 4, lane);
        for (int m = 2 * gw; m < MEMROWS; m += 2 * NGW) rows2_to_bf16(P.in[1] + (size_t)m * 1024, g_memb + (size_t)m * 1024, g_ssm + (size_t)m * 4, lane);
    }
    if (P.ws == nullptr) grid.sync();
    xcd_barrier(xbar);

    for (int l = 0; l < 4; ++l) {
        for (int sub = 0; sub < 5; ++sub) {
            unsigned char* ws = P.ws; asm volatile("" : "+s"(ws));
            int tid = threadIdx.x; asm volatile("" : "+v"(tid)); const int lane = tid & 63;
            switch (sub) {
            case 0: case 3: {
                for (int pass = (l == 0 && sub == 0) ? 0 : 1; pass < 2; ++pass) {
                    pg8::Gemm g; pg8::EpiProj E; E.ss = g_ss; E.act = 0; E.cat = 0; E.Ksh = g_Ksh; E.Vsh = g_Vsh; E.flog = g_cbuf; int cidx = bx;
                    if (pass == 0) { g.A = g_memb; g.Bt = g_Wmem; g.M = MEMROWS; g.N = 2048; g.K = 1024; E.ss = g_ssm; E.O = g_memkv; E.ldc = MEMKV_LD; cidx = (bx + G / 2) % G; }
                    else if (sub == 3) { g.A = g_hb; g.Bt = g_W1 + (size_t)l * 4096 * 1024; g.M = MROWS; g.N = DFF; g.K = 1024; E.O = g_hidden; E.ldc = DFF; E.act = 1; }
                    else if (l < 2) { g.A = g_hb; g.Bt = g_Wina + (size_t)l * 1792 * 1024; g.M = MROWS; g.N = 1792; g.K = 1024; E.O = g_proj; E.ldc = 1792; }
                    else if (l == 2) { g.A = g_hb; g.Bt = g_Wcat; g.M = MROWS; g.N = 2048; g.K = 1024; E.O = g_proj; E.ldc = 768; E.cat = 1; }
                    else { g.A = g_hb; g.Bt = g_Winb1; g.M = MROWS; g.N = 768; g.K = 1024; E.O = g_proj; E.ldc = 768; }
                    pg8::StaticOrder S; S.init(g.M, g.N, G, cidx);
                    pg8::gemm_phase<pg8::EpiProj, pg8::StaticOrder, true, true>(lds, g, S, E);
                }
            } break;
            case 1: {
                if (l == 2) {
                    LAS float* sb = (LAS float*)lds;
                    for (int ch = bx; ch < MROWS / 128; ch += G) {
                        const int r0 = ch * 128;
                        for (int e = tid; e < 1024; e += NTHREADS) {
                            const float f = g_cbuf[(size_t)r0 * 8 + e] + P.in[13][e & 7];
                            sb[e] = -(fmaxf(-f, 0.f) + log1pf(expf(-fabsf(f))));
                        }
                        __syncthreads();
                        if (tid < 8) { float a = 0.f; for (int r = 0; r < 128; ++r) { a += sb[r * 8 + tid]; sb[r * 8 + tid] = a; } g_totb[ch * 8 + tid] = a; }
                        __syncthreads();
                        for (int e = tid; e < 1024; e += NTHREADS) g_cbuf[(size_t)r0 * 8 + e] = sb[e];
                        float mx = 0.f;
                        for (int e = tid; e < 1024; e += NTHREADS) {
                            const bf16x8* kp = (const bf16x8*)(g_Ksh + (size_t)(r0 + (e >> 3)) * 512 + (e & 7) * 64); float s = 0.f;
#pragma unroll
                            for (int c = 0; c < 8; ++c) { const bf16x8 v = kp[c];
#pragma unroll
                                for (int j = 0; j < 8; ++j) { const float f = att::bf2f(v[j]); s += f * f; } }
                            mx = fmaxf(mx, s);
                        }
                        mx = fmaxf(mx, __shfl_xor(mx, 8)); mx = fmaxf(mx, __shfl_xor(mx, 16)); mx = fmaxf(mx, __shfl_xor(mx, 32));
                        if (lane < 8) atomicMax(g_ctl + CW_KMAX + (r0 >> 14) * 8 + lane, __float_as_uint(mx));
                        __syncthreads();
                    }
                    xcd_barrier(xbar);
                    for (int ch = bx; ch < MROWS / 128; ch += G) {
                        const int r0 = ch * 128, c0 = ch & ~127;
                        {
                          const int hd8 = tid & 7, j = tid >> 3; float a = 0.f;
                          if (c0 + j < ch) a += *(const GAS float*)(g_totb + (size_t)(c0 + j) * 8 + hd8);
                          if (c0 + 64 + j < ch) a += *(const GAS float*)(g_totb + (size_t)(c0 + 64 + j) * 8 + hd8);
                          a += __shfl_xor(a, 8); a += __shfl_xor(a, 16); a += __shfl_xor(a, 32);
                          if (lane < 8) sb[16 + (tid >> 6) * 8 + lane] = a;
                          __syncthreads();
                          if (tid < 8) { float s = 0.f;
#pragma unroll
                              for (int w = 0; w < 8; ++w) s += sb[16 + w * 8 + tid];
                              sb[tid] = s; }
                        }
                        __syncthreads();
                        for (int e = tid; e < 1024; e += NTHREADS) g_cbuf[(size_t)r0 * 8 + e] += sb[e & 7];
                        __syncthreads();
                    }
                    xcd_barrier(xbar);
                }
                {
                    const int ldp = (l < 2) ? 1792 : 768;
                    const int grp = __builtin_amdgcn_readfirstlane(tid >> 8);
                    LAS unsigned char* glds = lds + grp * att::GSZ;
                    LAS unsigned* gbar = (LAS unsigned*)(lds + 131072 + 16) + grp;
                    __syncthreads();
                    unsigned gen = (unsigned)__builtin_amdgcn_readfirstlane((int)*(volatile LAS unsigned*)gbar) >> 2;
                    for (int u = 2 * bx + grp; u < 3072; u += 2 * G) {
                        if (u < 2048) {
                            const int gq = u & 511, kk = u >> 9, cb = gq >> 1, bh = (cb & 7) * 2 + (cb >> 7), qb = (((cb >> 3) & 15) * 2 + (gq & 1)) * 4 + kk, hd = bh & 7, b = bh >> 3, q0 = 128 * qb;
                            const size_t rq = (size_t)b * SEQ + q0, rk = (size_t)b * SEQ;
                            if (l < 2) att::attn_unit<0>(glds, gbar, gen, g_proj + rq * 1792 + hd * 64, 1792, g_proj + rk * 1792 + 512 + hd * 64, 1792, g_proj + rk * 1792 + 1024 + hd * 64, 1792,
                                                         g_merged + rq * 768 + hd * 64, 768, nullptr, nullptr, 0.f, q0, (q0 >> 6) + 1);
                            else { const float kmax2 = sqrtf(__uint_as_float(g_ctl[CW_KMAX + b * 8 + hd])) * att::LOG2E;
                                   att::attn_unit<1>(glds, gbar, gen, g_proj + rq * 768 + hd * 64, 768, g_Ksh + rk * 512 + hd * 64, 512, g_Vsh + rk * 512 + hd * 64, 512,
                                                     g_merged + rq * 768 + hd * 64, 768, g_cbuf + rq * 8 + hd, g_cbuf + rk * 8 + hd, kmax2, q0, (q0 >> 6) + 1); }
                        } else {
                            const int u2 = u - 2048, rb = u2 & 255, hm = u2 >> 8; const size_t rq = (size_t)rb * 128; const int b = (int)(rq >> 14);
                            const bf16_t* qp = g_proj + rq * ldp + ((l < 2) ? 1536 : 512) + hm * 64;
                            const bf16_t* kp = g_memkv + (size_t)(b * NMEM) * MEMKV_LD + l * 512 + hm * 64;
                            att::attn_unit<2>(glds, gbar, gen, qp, ldp, kp, MEMKV_LD, kp + 256, MEMKV_LD, g_merged + rq * 768 + 512 + hm * 64, 768, nullptr, nullptr, 0.f, 0, 3);
                        }
                    }
                    __syncthreads();
                }
            } break;
            default: {
                pg8::Gemm g; g.M = MROWS; g.N = 1024;
                if (sub == 2) { g.A = g_merged; g.Bt = g_Wo + (size_t)l * 1024 * 768; g.K = 768; } else { g.A = g_hidden; g.Bt = g_W2 + (size_t)l * 1024 * 4096; g.K = DFF; }
                pg8::EpiRes E; E.hb = g_hb; E.ss = g_ss; E.red = (LAS float*)(lds + 131072 + 1024);
                pg8::StaticOrder S; S.init(g.M, g.N, G, bx);
                pg8::gemm_phase<pg8::EpiRes, pg8::StaticOrder, true, true>(lds, g, S, E);
            } break;
            }
            xcd_barrier(xbar);
        }
    }
    {
        unsigned char* ws = P.ws; asm volatile("" : "+s"(ws));
        int tid_l = threadIdx.x; asm volatile("" : "+v"(tid_l));
        const int tid = tid_l, lane = tid & 63, wave = __builtin_amdgcn_readfirstlane(tid >> 6);
        const int gw = bx * NWAVES + wave, NGW = G * NWAVES;
        const f32x4* gp = (const f32x4*)P.in[14] + lane;
        f32x4 gv[4];
#pragma unroll
        for (int j = 0; j < 4; ++j) gv[j] = gp[64 * j];
        for (int m = gw; m < MROWS; m += NGW) {
            float s = (lane < 4) ? *(const GAS float*)(g_ss + (size_t)m * 4 + lane) : 0.f;
            s = wave_sum(s);
            const float rs = 1.0f / sqrtf(s * (1.0f / 1024.0f) + pg8::RMS_EPS);
            const GAS u32x2* hr = (const GAS u32x2*)(g_hb + (size_t)m * 1024) + lane;
            GAS f32x4* xr = (GAS f32x4*)(g_hout + (size_t)m * 1024) + lane;
#pragma unroll
            for (int j = 0; j < 4; ++j) { const u32x2 w = hr[64 * j]; const f32x4 v = {pg8::bf_lo(w.x), pg8::bf_hi(w.x), pg8::bf_lo(w.y), pg8::bf_hi(w.y)}; xr[64 * j] = v * rs * gv[j]; }
        }
    }
}

extern "C" void kernel_launch(void* const* d_in, const int* in_sizes, int n_in, void* d_out, int out_size, void* d_ws, size_t ws_size, hipStream_t stream) {
    static int grid = 0;
    if (grid == 0) {
        if (n_in != 15 || in_sizes[0] != MROWS * D_MODEL || out_size != MROWS * D_MODEL || ws_size < WS_END) {
            fprintf(stderr, "kernel_launch: unexpected shapes / workspace (n_in %d, in0 %d, out %d, ws %zu < %zu); nothing launched\n", n_in, n_in > 0 ? in_sizes[0] : -1, out_size, ws_size, (size_t)WS_END);
            grid = -1; return;
        }
        int dev = 0, cus = 0, per_cu = 0;
        if (hipGetDevice(&dev) != hipSuccess || hipDeviceGetAttribute(&cus, hipDeviceAttributeMultiprocessorCount, dev) != hipSuccess) { fprintf(stderr, "kernel_launch: device query failed\n"); grid = -1; return; }
        if (hipFuncSetAttribute((const void*)yoco_fwd, hipFuncAttributeMaxDynamicSharedMemorySize, LDS_BYTES) != hipSuccess) { fprintf(stderr, "kernel_launch: hipFuncSetAttribute failed\n"); grid = -1; return; }
        if (hipOccupancyMaxActiveBlocksPerMultiprocessor(&per_cu, (const void*)yoco_fwd, NTHREADS, LDS_BYTES) != hipSuccess || per_cu < 1) { fprintf(stderr, "kernel_launch: occupancy query says %d\n", per_cu); per_cu = 1; }
        (void)hipGetLastError();
        grid = cus * 1;
    }
    if (grid < 0) return;
    (void)hipMemsetAsync((char*)d_ws + WS_CTL, 0, CTL_ZERO_BYTES, stream);
    Params p{};
    for (int i = 0; i < 15; ++i) p.in[i] = (const float*)d_in[i];
    p.out = (float*)d_out; p.ws = (unsigned char*)d_ws;
    void* args[] = {&p};
    hipError_t e = hipLaunchCooperativeKernel((const void*)yoco_fwd, dim3(grid), dim3(NTHREADS), args, LDS_BYTES, stream);
    if (e != hipSuccess) fprintf(stderr, "kernel_launch: cooperative launch failed: %s (grid %d)\n", hipGetErrorString(e), grid);
}
```
